# Optimizing an MI355X kernel written in HIP

```python
import math
import jax, jax.numpy as jnp
from jax import lax
import numpy as np

D_MODEL = 1024
BATCH = 4
SEQ = 4096
DEPTH = 4

GRID_W = 64
CTX_LEN = 256
N_MIXERS = 3
N_HEADS = 16
HEAD_DIM = D_MODEL // N_HEADS
WIN_H = 8
WIN_W = 16
CONV_W = 3
POOL_WINDOWS = (2, 4, 8, 16)
N_POOL_GROUPS = len(POOL_WINDOWS)
POOL_GC = D_MODEL // N_POOL_GROUPS
D_FF = ((8 * D_MODEL // 3 + 255) // 256) * 256
N_MOD = 6
EPS = 1e-6
N_LAYERS_A = (DEPTH + 2) // 3
N_LAYERS_B = (DEPTH + 1) // 3
N_LAYERS_C = DEPTH // 3

kernel_name = "hybrid_natten_shortconv_pool_dit"


def rms_norm(x, g):
    xf = x.astype(jnp.float32)
    y = xf * lax.rsqrt(jnp.mean(xf * xf, axis=-1, keepdims=True) + EPS)
    return (y * g.astype(jnp.float32)).astype(x.dtype)


def modulate(h, shift, scale):
    return h * (1 + scale) + shift


def swiglu(h, w1, w3, w2):
    return (jax.nn.silu(h @ w1) * (h @ w3)) @ w2


def neighbourhood_attention(hx, hc, w_qkv, w_o, rpb, need_ctx_out):
    B, N, D = hx.shape
    L = hc.shape[1]
    rows = N // GRID_W
    kh = min(WIN_H, rows)
    scale = HEAD_DIM ** -0.5

    qkv = (hx @ w_qkv).reshape(B, rows, GRID_W, 3, N_HEADS, HEAD_DIM)
    q = qkv[:, :, :, 0] * scale
    k = qkv[:, :, :, 1]
    v = qkv[:, :, :, 2]
    qkv_c = (hc @ w_qkv).reshape(B, L, 3, N_HEADS, HEAD_DIM)
    q_c = qkv_c[:, :, 0] * scale
    k_c = qkv_c[:, :, 1]
    v_c = qkv_c[:, :, 2]

    qc = np.arange(GRID_W)[:, None]
    kc = np.arange(GRID_W)[None, :]
    col_start = np.clip(qc - WIN_W // 2, 0, GRID_W - WIN_W)
    col_mask = (kc >= col_start) & (kc < col_start + WIN_W)
    dc_idx = np.clip(kc - qc, -(WIN_W - 1), WIN_W - 1) + (WIN_W - 1)
    rpb_cols = rpb.astype(jnp.float32)[:, :, dc_idx]

    def row_block(r):
        start = jnp.clip(r - kh // 2, 0, rows - kh)
        k_band = lax.dynamic_slice_in_dim(k, start, kh, axis=1)
        v_band = lax.dynamic_slice_in_dim(v, start, kh, axis=1)
        q_r = lax.dynamic_index_in_dim(q, r, axis=1, keepdims=False)
        dr_idx = start + jnp.arange(kh) - r + (WIN_H - 1)
        bias = jnp.take(rpb_cols, dr_idx, axis=1).transpose(0, 2, 1, 3)
        s_lat = jnp.einsum('bqhd,brkhd->bhqrk', q_r, k_band).astype(jnp.float32) + bias[None]
        s_lat = jnp.where(col_mask[None, None, :, None, :], s_lat, -jnp.inf)
        s_lat = s_lat.reshape(B, N_HEADS, GRID_W, kh * GRID_W)
        s_ctx = jnp.einsum('bqhd,blhd->bhql', q_r, k_c).astype(jnp.float32)
        p = jax.nn.softmax(jnp.concatenate([s_lat, s_ctx], axis=-1), axis=-1).astype(v.dtype)
        o = jnp.einsum('bhqk,bkhd->bqhd', p[..., :kh * GRID_W],
                       v_band.reshape(B, kh * GRID_W, N_HEADS, HEAD_DIM))
        o = o + jnp.einsum('bhql,blhd->bqhd', p[..., kh * GRID_W:], v_c)
        return o

    o = lax.map(row_block, jnp.arange(rows))
    yx = o.transpose(1, 0, 2, 3, 4).reshape(B, N, D) @ w_o

    yc = None
    if need_ctx_out:
        s = jnp.einsum('blhd,bmhd->bhlm', q_c, k_c).astype(jnp.float32)
        p = jax.nn.softmax(s, axis=-1).astype(v_c.dtype)
        yc = jnp.einsum('bhlm,bmhd->blhd', p, v_c).reshape(B, L, D) @ w_o
    return yx, yc


def dwconv3_centred(u, w):
    up = jnp.pad(u, ((0, 0), (1, 1), (0, 0)))
    return up[:, :-2] * w[0] + up[:, 1:-1] * w[1] + up[:, 2:] * w[2]


def short_conv_mixer(h, w_in, conv_w, w_out):
    gb, gc, val = jnp.split(h @ w_in, 3, axis=-1)
    return (gb * dwconv3_centred(gc * val, conv_w)) @ w_out


def multiscale_pool_mixer(h, w_grp, ch_scale):
    B, N, D = h.shape
    hf = h.astype(jnp.float32)
    cs = jnp.concatenate([jnp.zeros((B, 1, D), jnp.float32), jnp.cumsum(hf, axis=1)], axis=1)
    t = np.arange(N)
    outs = []
    for g, win in enumerate(POOL_WINDOWS):
        lo = np.maximum(t - win // 2, 0)
        hi = np.minimum(t + win // 2, N)
        cnt = (hi - lo).astype(np.float32)
        sl = slice(g * POOL_GC, (g + 1) * POOL_GC)
        mean = (cs[:, hi, sl] - cs[:, lo, sl]) / cnt[None, :, None]
        outs.append(mean - hf[..., sl])
    pooled = jnp.stack(outs, axis=2).astype(h.dtype)
    y = jnp.einsum('bngc,gcd->bngd', pooled, w_grp).reshape(B, N, D)
    return y * ch_scale


def setup_inputs(seed: int = 0) -> dict:
    key = jax.random.key(seed)
    ks = jax.random.split(key, 20)
    D, F = D_MODEL, D_FF
    f32 = jnp.float32

    def nrm(k, shape, s):
        return jax.random.normal(k, shape, f32) * s

    return {
        "x": nrm(ks[0], (BATCH, SEQ, D), 1.0),
        "c": nrm(ks[1], (BATCH, D), 1.0),
        "ctx": nrm(ks[2], (BATCH, CTX_LEN, D), 1.0),
        "c_ctx": nrm(ks[3], (D,), 1.0),
        "adaln_w": nrm(ks[4], (DEPTH, D, N_MOD * D), 0.5 * D ** -0.5),
        "adaln_b": nrm(ks[5], (DEPTH, N_MOD * D), 0.02),
        "norm_mix_g": 1.0 + nrm(ks[6], (DEPTH, D), 0.05),
        "norm_ffn_g": 1.0 + nrm(ks[7], (DEPTH, D), 0.05),
        "ffn_w1": nrm(ks[8], (DEPTH, D, F), D ** -0.5),
        "ffn_w3": nrm(ks[9], (DEPTH, D, F), D ** -0.5),
        "ffn_w2": nrm(ks[10], (DEPTH, F, D), F ** -0.5),
        "na_w_qkv": nrm(ks[11], (N_LAYERS_A, D, 3 * D), D ** -0.5),
        "na_w_o": nrm(ks[12], (N_LAYERS_A, D, D), D ** -0.5),
        "na_rpb": nrm(ks[13], (N_LAYERS_A, N_HEADS, 2 * WIN_H - 1, 2 * WIN_W - 1), 0.2),
        "sc_w_in": nrm(ks[14], (N_LAYERS_B, D, 3 * D), D ** -0.5),
        "sc_conv_w": nrm(ks[15], (N_LAYERS_B, CONV_W, D), CONV_W ** -0.5),
        "sc_w_out": nrm(ks[16], (N_LAYERS_B, D, D), D ** -0.5),
        "pool_w": nrm(ks[17], (N_LAYERS_C, N_POOL_GROUPS, POOL_GC, POOL_GC), POOL_GC ** -0.5),
        "pool_scale": 1.0 + nrm(ks[18], (N_LAYERS_C, D), 0.1),
        "final_g": 1.0 + nrm(ks[19], (D,), 0.05),
    }


def reference(x, c, ctx, c_ctx, adaln_w, adaln_b, norm_mix_g, norm_ffn_g, ffn_w1, ffn_w3, ffn_w2,
              na_w_qkv, na_w_o, na_rpb, sc_w_in, sc_conv_w, sc_w_out, pool_w, pool_scale, final_g):
    silu_c = jax.nn.silu(c)
    silu_cc = jax.nn.silu(c_ctx)
    for layer in range(DEPTH):
        kind = layer % N_MIXERS
        j = layer // N_MIXERS
        need_ctx_out = layer < DEPTH - 1

        mx = jnp.split((silu_c @ adaln_w[layer] + adaln_b[layer])[:, None, :], N_MOD, axis=-1)
        mc = jnp.split(silu_cc @ adaln_w[layer] + adaln_b[layer], N_MOD, axis=-1)

        hx = modulate(rms_norm(x, norm_mix_g[layer]), mx[0], mx[1])
        if kind == 0 or need_ctx_out:
            hc = modulate(rms_norm(ctx, norm_mix_g[layer]), mc[0], mc[1])

        if kind == 0:
            yx, yc = neighbourhood_attention(hx, hc, na_w_qkv[j], na_w_o[j], na_rpb[j], need_ctx_out)
        elif kind == 1:
            yx = short_conv_mixer(hx, sc_w_in[j], sc_conv_w[j], sc_w_out[j])
            yc = short_conv_mixer(hc, sc_w_in[j], sc_conv_w[j], sc_w_out[j]) if need_ctx_out else None
        else:
            yx = multiscale_pool_mixer(hx, pool_w[j], pool_scale[j])
            yc = multiscale_pool_mixer(hc, pool_w[j], pool_scale[j]) if need_ctx_out else None

        x = x + mx[2] * yx
        hx = modulate(rms_norm(x, norm_ffn_g[layer]), mx[3], mx[4])
        x = x + mx[5] * swiglu(hx, ffn_w1[layer], ffn_w3[layer], ffn_w2[layer])

        if need_ctx_out:
            ctx = ctx + mc[2] * yc
            hc = modulate(rms_norm(ctx, norm_ffn_g[layer]), mc[3], mc[4])
            ctx = ctx + mc[5] * swiglu(hc, ffn_w1[layer], ffn_w3[layer], ffn_w2[layer])
    return rms_norm(x, final_g)
```

```cpp
#include <hip/hip_runtime.h>
#include <hip/hip_cooperative_groups.h>
#include <cstdio>
#include <cstdint>
namespace cg = cooperative_groups;

#define LAS __attribute__((address_space(3)))
typedef unsigned short bf16_t;
typedef short bf16x8 __attribute__((ext_vector_type(8)));
typedef float f32x4 __attribute__((ext_vector_type(4)));
typedef float f32x2 __attribute__((ext_vector_type(2)));
typedef unsigned u32x4 __attribute__((ext_vector_type(4)));
typedef unsigned u32x2 __attribute__((ext_vector_type(2)));

constexpr int D = 1024, NB = 4, SEQ = 4096, CTXL = 256, NLAYER = 4, FF = 2816, NH = 16, HD = 64;
constexpr int MLAT = NB * SEQ, MCTX = NB * CTXL, MTOT = MLAT + MCTX;
constexpr int NMOD = 6 * D;
constexpr float EPS = 1e-6f;
constexpr float LOG2E = 1.4426950408889634f;
constexpr float QSCALE = 0.125f * LOG2E;

constexpr size_t MiB = 1u << 20;
constexpr size_t WS_MODS = 0;
constexpr size_t WS_WQKV = 1 * MiB;
constexpr size_t WS_WO = 13 * MiB;
constexpr size_t WS_WSCIN = 17 * MiB;
constexpr size_t WS_WSCOUT = 23 * MiB;
constexpr size_t WS_WPOOL = 25 * MiB;
constexpr size_t WS_W13 = 26 * MiB;
constexpr size_t WS_W2 = 70 * MiB;
constexpr size_t WS_X = 92 * MiB;
constexpr size_t WS_H = 160 * MiB;
constexpr size_t WS_Q = 194 * MiB;
constexpr size_t WS_K = 228 * MiB;
constexpr size_t WS_VT = 262 * MiB;
constexpr size_t WS_O = 296 * MiB;
constexpr size_t WS_G = 194 * MiB;
constexpr size_t WS_END = 330 * MiB;
static_assert(WS_G + (size_t)MTOT * FF * 2 <= WS_O, "G overlay");

constexpr int LDS_BYTES = 147456;
constexpr int NWAVES = 8, NTHREADS = 512;

__device__ __forceinline__ int opaque_tid() { int t = threadIdx.x; asm volatile("" : "+v"(t)); return t; }
__device__ __forceinline__ unsigned cvt_pk_bf16(float lo, float hi) { unsigned r; asm volatile("v_cvt_pk_bf16_f32 %0, %1, %2" : "=v"(r) : "v"(lo), "v"(hi)); return r; }
__device__ __forceinline__ float bf_lo(unsigned w) { return __uint_as_float(w << 16); }
__device__ __forceinline__ float bf_hi(unsigned w) { return __uint_as_float(w & 0xffff0000u); }
__device__ __forceinline__ float bf2f(bf16_t v) { return __uint_as_float(((unsigned)v) << 16); }
__device__ __forceinline__ float silu_f(float x) { return x * __builtin_amdgcn_rcpf(1.0f + __expf(-x)); }
__device__ __forceinline__ float wave_sum(float v) {
#pragma unroll
    for (int o = 1; o < 64; o <<= 1) v += __shfl_xor(v, o);
    return v;
}
__device__ __forceinline__ float wave_max(float v) {
#pragma unroll
    for (int o = 1; o < 64; o <<= 1) v = fmaxf(v, __shfl_xor(v, o));
    return v;
}

namespace pg8 {
constexpr int BM = 256, BK = 64, HALF = 128, HTB = HALF * BK * 2, STAGE_BYTES = 8 * HTB, NXCD = 8, WGM = 8;
__host__ __device__ __forceinline__ int lds_byte(int r, int c) { const int st = (r >> 4) * 2 + (c >> 5), rr = r & 15, cc = c & 31, ob = rr * 64 + cc * 2; return st * 1024 + (ob ^ (((ob >> 9) & 1) << 5)); }
__host__ __device__ __forceinline__ void stage_rc(int b, int& R, int& C) { const int st = b / 1024, sb = b % 1024, swz = sb ^ (((sb >> 9) & 1) << 5); R = (st >> 1) * 16 + swz / 64; C = (st & 1) * 32 + (swz % 64) / 2; }
__host__ __device__ __forceinline__ int perm32(int rho) { const int n = rho >> 4, i = rho & 15; return 8 * (i >> 2) + 4 * n + (i & 3); }

struct Unit { const char* a; const char* b; int pm, pn, fam; };

struct Sched {
    const char* A1; const char* B1; size_t tsA1, tsB1, apn; int nM1, nN1, nwg1;
    const char* A2; const char* B2; size_t tsA2, tsB2; int nM2, nN2;
    int nwg, G, c;
    __device__ void init1(const void* A, size_t tsA, const void* B, size_t tsB, int nM, int nN, int G_, int c_) {
        A1 = (const char*)A; B1 = (const char*)B; tsA1 = tsA; tsB1 = tsB; apn = 0; nM1 = nM; nN1 = nN; nwg1 = nM * nN;
        A2 = nullptr; B2 = nullptr; tsA2 = 0; tsB2 = 0; nM2 = 0; nN2 = 0; nwg = nwg1; G = G_; c = c_;
    }
    __device__ void add2(const void* A, size_t tsA, const void* B, size_t tsB, int nM, int nN) {
        A2 = (const char*)A; B2 = (const char*)B; tsA2 = tsA; tsB2 = tsB; nM2 = nM; nN2 = nN; nwg = nwg1 + nM * nN;
    }
    __device__ bool next(int i, Unit& u) const {
        const long L = (long)i * G + c; if (L >= nwg) return false;
        int wgid = (int)L; { const int q = nwg / NXCD, r = nwg % NXCD, xcd = wgid % NXCD, off = wgid / NXCD; wgid = (xcd < r ? xcd * (q + 1) : r * (q + 1) + (xcd - r) * q) + off; }
        if (wgid < nwg1) {
            const int nig = WGM * nN1, gid = wgid / nig, fm = gid * WGM, gsz = (nM1 - fm) < WGM ? (nM1 - fm) : WGM;
            u.pm = fm + ((wgid % nig) % gsz); u.pn = (wgid % nig) / gsz; u.fam = 0;
            u.a = A1 + (size_t)u.pm * tsA1 + (size_t)u.pn * apn; u.b = B1 + (size_t)u.pn * tsB1;
        } else {
            const int w2 = wgid - nwg1; u.pm = w2 % nM2; u.pn = w2 / nM2; u.fam = 1;
            u.a = A2 + (size_t)u.pm * tsA2; u.b = B2 + (size_t)u.pn * tsB2;
        }
        return true;
    }
};

typedef f32x4 Acc[2][2][4][2];

__device__ __forceinline__ void store_plain(const Acc& acc, bf16_t* base, size_t ldc, int row0, int col0, float sc, int wr, int wc, int fr, int fq) {
#pragma unroll
    for (int ai = 0; ai < 2; ++ai)
#pragma unroll
        for (int m = 0; m < 4; ++m) {
            bf16_t* rowp = base + (size_t)(row0 + wr * 64 + fr + ai * HALF + m * 16) * ldc + col0 + wc * 32 + 8 * fq;
#pragma unroll
            for (int bj = 0; bj < 2; ++bj) {
                const f32x4 v0 = acc[ai][bj][m][0] * sc, v1 = acc[ai][bj][m][1] * sc;
                u32x4 w; w.x = cvt_pk_bf16(v0[0], v0[1]); w.y = cvt_pk_bf16(v0[2], v0[3]); w.z = cvt_pk_bf16(v1[0], v1[1]); w.w = cvt_pk_bf16(v1[2], v1[3]);
                *(u32x4*)(rowp + bj * HALF) = w;
            }
        }
}
template <int ACT>
__device__ __forceinline__ void store_pair(const Acc& acc, bf16_t* base, size_t ldc, int row0, int col0, int wr, int wc, int fr, int fq) {
#pragma unroll
    for (int ai = 0; ai < 2; ++ai)
#pragma unroll
        for (int m = 0; m < 4; ++m) {
            bf16_t* rowp = base + (size_t)(row0 + wr * 64 + fr + ai * HALF + m * 16) * ldc + col0 + wc * 32 + 8 * fq;
            float o[8];
#pragma unroll
            for (int n = 0; n < 2; ++n)
#pragma unroll
                for (int e = 0; e < 4; ++e) { const float a = acc[ai][0][m][n][e], b = acc[ai][1][m][n][e]; o[n * 4 + e] = (ACT == 1 ? silu_f(a) : a) * b; }
            u32x4 w; w.x = cvt_pk_bf16(o[0], o[1]); w.y = cvt_pk_bf16(o[2], o[3]); w.z = cvt_pk_bf16(o[4], o[5]); w.w = cvt_pk_bf16(o[6], o[7]);
            *(u32x4*)rowp = w;
        }
}

struct EpiQKV {
    static constexpr bool PERM = true;
    bf16_t *Q, *K, *VT;
    __device__ __forceinline__ void operator()(const Acc& acc, const Unit& u, int wr, int wc, int fr, int fq) const {
        if (u.fam == 0) {
            if (u.pn < 4) store_plain(acc, Q, D, u.pm * BM, u.pn * BM, QSCALE, wr, wc, fr, fq);
            else store_plain(acc, K, D, u.pm * BM, (u.pn - 4) * BM, 1.0f, wr, wc, fr, fq);
        } else store_plain(acc, VT, MTOT, u.pm * BM, u.pn * BM, 1.0f, wr, wc, fr, fq);
    }
};
struct EpiSCin {
    static constexpr bool PERM = true;
    bf16_t *GB, *U;
    __device__ __forceinline__ void operator()(const Acc& acc, const Unit& u, int wr, int wc, int fr, int fq) const {
        if (u.pn < 4) store_plain(acc, GB, D, u.pm * BM, u.pn * BM, 1.0f, wr, wc, fr, fq);
        else store_pair<0>(acc, U, D, u.pm * BM, (u.pn - 4) * HALF, wr, wc, fr, fq);
    }
};
struct EpiSwi {
    static constexpr bool PERM = true;
    bf16_t* Gb;
    __device__ __forceinline__ void operator()(const Acc& acc, const Unit& u, int wr, int wc, int fr, int fq) const {
        store_pair<1>(acc, Gb, FF, u.pm * BM, u.pn * HALF, wr, wc, fr, fq);
    }
};
struct EpiRes {
    static constexpr bool PERM = false;
    const float* res_lat; const float* res_ctx; float* X; const float* gate;   const float* cscale;
    __device__ __forceinline__ void operator()(const Acc& acc, const Unit& u, int wr, int wc, int fr, int fq) const {
        const int row0 = u.pm * BM, colb = u.pn * BM + wc * 32 + 4 * fq;
        const bool lat = row0 < MLAT; const int mb = lat ? (row0 >> 12) : 4;
        const float* gp = gate + (size_t)mb * NMOD;
        const float* rbase = lat ? res_lat : res_ctx - (size_t)MLAT * D;
        f32x4 gv[2][2];
#pragma unroll
        for (int bj = 0; bj < 2; ++bj)
#pragma unroll
            for (int n = 0; n < 2; ++n) { const int c = colb + bj * HALF + n * 16; f32x4 g = *(const f32x4*)(gp + c); if (cscale) g = g * *(const f32x4*)(cscale + c); gv[bj][n] = g; }
#pragma unroll
        for (int ai = 0; ai < 2; ++ai)
#pragma unroll
            for (int m = 0; m < 4; ++m) {
                const size_t off = (size_t)(row0 + wr * 64 + fr + ai * HALF + m * 16) * D;
#pragma unroll
                for (int bj = 0; bj < 2; ++bj)
#pragma unroll
                    for (int n = 0; n < 2; ++n) { const int c = colb + bj * HALF + n * 16; const f32x4 r = *(const f32x4*)(rbase + off + c); *(f32x4*)(X + off + c) = r + gv[bj][n] * acc[ai][bj][m][n]; }
                asm volatile("" ::: "memory");
            }
    }
};

template <class Epi>
__device__ __forceinline__ void gemm_phase(LAS unsigned char* lds, const int K, const int lda, const int ldb, const Sched& S, const Epi& E) {
    const int tid = opaque_tid(), wid = __builtin_amdgcn_readfirstlane(tid >> 6), lane = tid & 63, wr = wid >> 2, wc = wid & 3, fr = lane & 15, fq = lane >> 4;
    const int nt = K / BK;
    unsigned voffA[2], voffB[2];
#pragma unroll
    for (int i = 0; i < 2; ++i) { int R, C; stage_rc(tid * 16 + i * 8192, R, C); const int Rb = Epi::PERM ? ((R & ~31) + perm32(R & 31)) : R;
        voffA[i] = (unsigned)(R * lda + C) * 2u; voffB[i] = (unsigned)(Rb * ldb + C) * 2u; }
    const size_t kstep = (size_t)(BK * 2);
    const size_t hsA = (size_t)HALF * lda * 2, hsB = (size_t)HALF * ldb * 2;
    const unsigned ldsw = (unsigned)wid * 1024u;
    const int aoff = lds_byte(wr * 64 + fr, fq * 8), boff = lds_byte(wc * 32 + fr, fq * 8);
#define PG8_SA(b, h) (((b) * 2 + (h)) * HTB)
#define PG8_SB(b, h) ((4 + (b) * 2 + (h)) * HTB)
#define PG8_STAGE(bufoff, gbase, voff) do { _Pragma("unroll") for (int _i = 0; _i < 2; ++_i) \
        __builtin_amdgcn_global_load_lds((const unsigned*)((const char*)(gbase) + (voff)[_i]), (LAS unsigned*)(lds + (bufoff) + ldsw + _i * 8192), 16, 0, 0); } while (0)
#define PG8_LDA(dst, b, h) do { _Pragma("unroll") for (int m = 0; m < 4; ++m) _Pragma("unroll") for (int k = 0; k < 2; ++k) dst[m][k] = *(const LAS bf16x8*)(lds + PG8_SA(b, h) + aoff + m * 2048 + k * 1024); } while (0)
#define PG8_LDB(dst, b, h) do { _Pragma("unroll") for (int n = 0; n < 2; ++n) _Pragma("unroll") for (int k = 0; k < 2; ++k) dst[n][k] = *(const LAS bf16x8*)(lds + PG8_SB(b, h) + boff + n * 2048 + k * 1024); } while (0)
#define PG8_MMA(ai, bj, At, Bt) do { __builtin_amdgcn_s_setprio(1); _Pragma("unroll") for (int m = 0; m < 4; ++m) _Pragma("unroll") for (int n = 0; n < 2; ++n) _Pragma("unroll") for (int k = 0; k < 2; ++k) \
        acc[ai][bj][m][n] = __builtin_amdgcn_mfma_f32_16x16x32_bf16(Bt[n][k], At[m][k], acc[ai][bj][m][n], 0, 0, 0); __builtin_amdgcn_s_setprio(0); } while (0)
#define PG8_WAIT_V(n) asm volatile("s_waitcnt vmcnt(" #n ")" ::: "memory")
#define PG8_WAIT_L(n) asm volatile("s_waitcnt lgkmcnt(" #n ")" ::: "memory")
#define PG8_BAR __builtin_amdgcn_s_barrier()
#define PG8_SCHED __builtin_amdgcn_sched_barrier(0)
    Unit cur, nxt; int ui = 0;
    if (!S.next(0, cur)) return;
    Acc acc;
#pragma unroll
    for (int a = 0; a < 2; ++a)
#pragma unroll
        for (int b = 0; b < 2; ++b)
#pragma unroll
            for (int m = 0; m < 4; ++m)
#pragma unroll
                for (int n = 0; n < 2; ++n) acc[a][b][m][n] = (f32x4){0.f, 0.f, 0.f, 0.f};
    bf16x8 At[4][2], B0[2][2], B1[2][2];
    const char* cA = cur.a; const char* cB = cur.b;
    PG8_STAGE(PG8_SB(0, 0), cB, voffB); PG8_STAGE(PG8_SB(0, 1), cB + hsB, voffB); PG8_STAGE(PG8_SA(0, 0), cA, voffA); PG8_STAGE(PG8_SA(0, 1), cA + hsA, voffA);
    if (wr == 1) PG8_BAR;
    PG8_WAIT_V(2); PG8_BAR;
    PG8_STAGE(PG8_SB(1, 0), cB + kstep, voffB); PG8_STAGE(PG8_SA(1, 0), cA + kstep, voffA); PG8_STAGE(PG8_SB(1, 1), cB + hsB + kstep, voffB);
    PG8_WAIT_V(6); PG8_BAR;
    for (;;) {
        const bool has_next = S.next(ui + 1, nxt);
        const char* nA = has_next ? nxt.a : cA; const char* nB = has_next ? nxt.b : cB;
        for (int t = 0; t < nt; t += 2) {
            const bool last = (t == nt - 2);
            const char* a1 = cA + (size_t)(t + 1) * kstep;
            const char* a2 = last ? nA : cA + (size_t)(t + 2) * kstep; const char* b2 = last ? nB : cB + (size_t)(t + 2) * kstep;
            const char* a3 = a2 + kstep; const char* b3 = b2 + kstep;
            PG8_LDB(B0, 0, 0); PG8_LDB(B1, 0, 1); PG8_SCHED; PG8_LDA(At, 0, 0); PG8_STAGE(PG8_SA(1, 1), a1 + hsA, voffA);
            PG8_WAIT_V(8); PG8_WAIT_L(0); PG8_BAR; PG8_MMA(0, 0, At, B0); PG8_MMA(0, 1, At, B1); PG8_BAR; PG8_SCHED;
            PG8_LDA(At, 0, 1); PG8_STAGE(PG8_SB(0, 0), b2, voffB); PG8_STAGE(PG8_SB(0, 1), b2 + hsB, voffB); PG8_STAGE(PG8_SA(0, 0), a2, voffA);
            PG8_WAIT_V(8); PG8_WAIT_L(0); PG8_BAR; PG8_MMA(1, 0, At, B0); PG8_MMA(1, 1, At, B1); PG8_BAR; PG8_SCHED;
            PG8_LDB(B0, 1, 0); PG8_LDB(B1, 1, 1); PG8_SCHED; PG8_LDA(At, 1, 0); PG8_STAGE(PG8_SA(0, 1), a2 + hsA, voffA);
            PG8_WAIT_V(8); PG8_WAIT_L(0); PG8_BAR; PG8_MMA(0, 0, At, B0); PG8_MMA(0, 1, At, B1); PG8_BAR; PG8_SCHED;
            PG8_LDA(At, 1, 1); PG8_STAGE(PG8_SB(1, 0), b3, voffB); PG8_STAGE(PG8_SB(1, 1), b3 + hsB, voffB); PG8_STAGE(PG8_SA(1, 0), a3, voffA);
            PG8_WAIT_V(8); PG8_WAIT_L(0); PG8_BAR; PG8_MMA(1, 0, At, B0); PG8_MMA(1, 1, At, B1); PG8_BAR; PG8_SCHED;
        }
        if (wr == 0) PG8_BAR;
        E(acc, cur, wr, wc, fr, fq);
        if (!has_next) break;
#pragma unroll
        for (int a = 0; a < 2; ++a)
#pragma unroll
            for (int b = 0; b < 2; ++b)
#pragma unroll
                for (int m = 0; m < 4; ++m)
#pragma unroll
                    for (int n = 0; n < 2; ++n) acc[a][b][m][n] = (f32x4){0.f, 0.f, 0.f, 0.f};
        cur = nxt; cA = nA; cB = nB; ++ui;
        if (wr == 1) PG8_BAR;
    }
    PG8_WAIT_V(0);
    PG8_BAR;
#undef PG8_SA
#undef PG8_SB
#undef PG8_STAGE
#undef PG8_LDA
#undef PG8_LDB
#undef PG8_MMA
#undef PG8_WAIT_V
#undef PG8_WAIT_L
#undef PG8_BAR
#undef PG8_SCHED
}
}

struct Args {
    const float *x, *c, *ctx, *c_ctx, *adaln_w, *adaln_b, *norm_mix_g, *norm_ffn_g, *ffn_w1, *ffn_w3, *ffn_w2;
    const float *na_w_qkv, *na_w_o, *na_rpb, *sc_w_in, *sc_conv_w, *sc_w_out, *pool_w, *pool_scale, *final_g;
    float* out; unsigned char* ws;
};

__device__ __forceinline__ void transpose_item(const float* W, int N, int k0, int n0, bf16_t* WT, int ldk, int row_base, LAS float* scr, int lane) {
#pragma unroll 8
    for (int i = 0; i < 32; ++i) { const int kk = 2 * i + (lane >> 5); scr[kk * 33 + (lane & 31)] = W[(size_t)(k0 + kk) * N + n0 + (lane & 31)]; }
    asm volatile("s_waitcnt lgkmcnt(0)" ::: "memory");
    const int c = lane & 7;
#pragma unroll
    for (int j = 0; j < 4; ++j) { const int n = (lane >> 3) + 8 * j; const LAS float* s = scr + (8 * c) * 33 + n;
        u32x4 o; o.x = cvt_pk_bf16(s[0 * 33], s[1 * 33]); o.y = cvt_pk_bf16(s[2 * 33], s[3 * 33]); o.z = cvt_pk_bf16(s[4 * 33], s[5 * 33]); o.w = cvt_pk_bf16(s[6 * 33], s[7 * 33]);
        *(u32x4*)(WT + (size_t)(row_base + n) * ldk + k0 + 8 * c) = o; }
    asm volatile("s_waitcnt lgkmcnt(0)" ::: "memory");
}

__device__ __forceinline__ void prologue_phase(const Args& P, LAS unsigned char* lds) {
    const int tid = opaque_tid(), lane = tid & 63, wave = __builtin_amdgcn_readfirstlane(tid >> 6);
    unsigned char* ws = P.ws;
    LAS float* S = (LAS float*)lds;
    LAS float* red = (LAS float*)(lds + 5 * 1024 * 4);
    for (int i = tid; i < 5 * D; i += NTHREADS) { const float v = i < 4 * D ? P.c[i] : P.c_ctx[i - 4 * D]; S[i] = v / (1.0f + __expf(-v)); }
    __syncthreads();
    float* mods = (float*)(ws + WS_MODS);
    for (int item = blockIdx.x; item < NLAYER * (NMOD / 32); item += gridDim.x) {
        const int layer = item / (NMOD / 32), c0 = (item % (NMOD / 32)) * 32;
        const int kk = lane >> 3, cgp = lane & 7;
        const float* W = P.adaln_w + (size_t)layer * D * NMOD + c0 + 4 * cgp;
        f32x4 acc[5];
#pragma unroll
        for (int b = 0; b < 5; ++b) acc[b] = (f32x4){0.f, 0.f, 0.f, 0.f};
#pragma unroll 4
        for (int i = 0; i < 16; ++i) {
            const int k = 128 * wave + 8 * i + kk;
            const f32x4 wv = *(const f32x4*)(W + (size_t)k * NMOD);
#pragma unroll
            for (int b = 0; b < 5; ++b) acc[b] += wv * S[b * D + k];
        }
#pragma unroll
        for (int b = 0; b < 5; ++b)
#pragma unroll
            for (int e = 0; e < 4; ++e) { float v = acc[b][e]; v += __shfl_xor(v, 8); v += __shfl_xor(v, 16); v += __shfl_xor(v, 32); acc[b][e] = v; }
        if (lane < 8) {
#pragma unroll
            for (int b = 0; b < 5; ++b)
#pragma unroll
                for (int e = 0; e < 4; ++e) red[(wave * 5 + b) * 32 + 4 * cgp + e] = acc[b][e];
        }
        __syncthreads();
        if (tid < 160) { const int b = tid >> 5, cc = tid & 31; float s = P.adaln_b[(size_t)layer * NMOD + c0 + cc];
#pragma unroll
            for (int w = 0; w < 8; ++w) s += red[(w * 5 + b) * 32 + cc];
            mods[((size_t)layer * 5 + b) * NMOD + c0 + cc] = s; }
        __syncthreads();
    }
    LAS float* scr = (LAS float*)(lds + wave * 16384);
    const int gw = blockIdx.x * NWAVES + wave, NGW = gridDim.x * NWAVES;
    constexpr int I_QKV = 16 * 96, I_WO = 16 * 32, I_POOL = 4 * 8, I_W1 = 16 * 88, I_W2 = 44 * 32;
    constexpr int T_QKV = 2 * I_QKV, T_WO = 2 * I_WO, T_SCIN = I_QKV, T_SCOUT = I_WO, T_POOL = 4 * I_POOL, T_W1 = 4 * I_W1, T_W3 = 4 * I_W1, T_W2 = 4 * I_W2;
    constexpr int NITEMS = T_QKV + T_WO + T_SCIN + T_SCOUT + T_POOL + T_W1 + T_W3 + T_W2;
    for (int it = gw; it < NITEMS; it += NGW) {
        int r = it;
        if (r < T_QKV) { const int l = r / I_QKV, q = r % I_QKV, kb = q / 96, nb = q % 96;
            transpose_item(P.na_w_qkv + (size_t)l * D * 3 * D, 3 * D, 64 * kb, 32 * nb, (bf16_t*)(ws + WS_WQKV) + (size_t)l * 3 * D * D, D, 32 * nb, scr, lane); continue; } r -= T_QKV;
        if (r < T_WO) { const int l = r / I_WO, q = r % I_WO, kb = q / 32, nb = q % 32;
            transpose_item(P.na_w_o + (size_t)l * D * D, D, 64 * kb, 32 * nb, (bf16_t*)(ws + WS_WO) + (size_t)l * D * D, D, 32 * nb, scr, lane); continue; } r -= T_WO;
        if (r < T_SCIN) { const int kb = r / 96, nb = r % 96, n0 = 32 * nb;
            int rb; if (n0 < D) rb = n0; else if (n0 < 2 * D) { const int j = n0 - D; rb = D + (j / 128) * 256 + (j % 128); } else { const int j = n0 - 2 * D; rb = D + (j / 128) * 256 + 128 + (j % 128); }
            transpose_item(P.sc_w_in, 3 * D, 64 * kb, n0, (bf16_t*)(ws + WS_WSCIN), D, rb, scr, lane); continue; } r -= T_SCIN;
        if (r < T_SCOUT) { const int kb = r / 32, nb = r % 32;
            transpose_item(P.sc_w_out, D, 64 * kb, 32 * nb, (bf16_t*)(ws + WS_WSCOUT), D, 32 * nb, scr, lane); continue; } r -= T_SCOUT;
        if (r < T_POOL) { const int g = r / I_POOL, q = r % I_POOL, kb = q / 8, nb = q % 8;
            transpose_item(P.pool_w + (size_t)g * 256 * 256, 256, 64 * kb, 32 * nb, (bf16_t*)(ws + WS_WPOOL) + (size_t)g * 256 * 256, 256, 32 * nb, scr, lane); continue; } r -= T_POOL;
        if (r < T_W1 + T_W3) { const int which = r / T_W1; r -= which * T_W1; const int l = r / I_W1, q = r % I_W1, kb = q / 88, nb = q % 88, n0 = 32 * nb;
            const float* src = (which ? P.ffn_w3 : P.ffn_w1) + (size_t)l * D * FF;
            transpose_item(src, FF, 64 * kb, n0, (bf16_t*)(ws + WS_W13) + (size_t)l * 2 * FF * D, D, (n0 / 128) * 256 + which * 128 + (n0 % 128), scr, lane); continue; } r -= T_W1 + T_W3;
        { const int l = r / I_W2, q = r % I_W2, kb = q / 32, nb = q % 32;
            transpose_item(P.ffn_w2 + (size_t)l * FF * D, D, 64 * kb, 32 * nb, (bf16_t*)(ws + WS_W2) + (size_t)l * D * FF, FF, 32 * nb, scr, lane); }
    }
}

__device__ __forceinline__ void norm_phase(const float* src_lat, const float* src_ctx, const float* g, const float* mods_l, int shift_i, int scale_i, bf16_t* H, int nrows) {
    const int tid = opaque_tid(), lane = tid & 63, wave = __builtin_amdgcn_readfirstlane(tid >> 6);
    const int gw = blockIdx.x * NWAVES + wave, NGW = gridDim.x * NWAVES;
    for (int m = gw; m < nrows; m += NGW) {
        const float* xr = m < MLAT ? src_lat + (size_t)m * D : src_ctx + (size_t)(m - MLAT) * D;
        const int mb = m < MLAT ? (m >> 12) : 4;
        const float* sh = mods_l + (size_t)mb * NMOD + shift_i * D; const float* sc = mods_l + (size_t)mb * NMOD + scale_i * D;
        f32x4 v[4]; float s = 0.f;
#pragma unroll
        for (int j = 0; j < 4; ++j) { v[j] = *(const f32x4*)(xr + 4 * lane + 256 * j); s += (v[j][0] * v[j][0] + v[j][1] * v[j][1]) + (v[j][2] * v[j][2] + v[j][3] * v[j][3]); }
        const float rstd = 1.0f / sqrtf(wave_sum(s) * (1.0f / D) + EPS);
#pragma unroll
        for (int j = 0; j < 4; ++j) { const int c = 4 * lane + 256 * j;
            const f32x4 gv = *(const f32x4*)(g + c), scv = *(const f32x4*)(sc + c), shv = *(const f32x4*)(sh + c);
            const f32x4 o = (v[j] * rstd) * gv * (scv + 1.0f) + shv;
            u32x2 w; w.x = cvt_pk_bf16(o[0], o[1]); w.y = cvt_pk_bf16(o[2], o[3]);
            *(u32x2*)(H + (size_t)m * D + c) = w; }
    }
}
__device__ __forceinline__ void final_norm_phase(const float* X, const float* g, float* out) {
    const int tid = opaque_tid(), lane = tid & 63, wave = __builtin_amdgcn_readfirstlane(tid >> 6);
    const int gw = blockIdx.x * NWAVES + wave, NGW = gridDim.x * NWAVES;
    for (int m = gw; m < MLAT; m += NGW) {
        const float* xr = X + (size_t)m * D;
        f32x4 v[4]; float s = 0.f;
#pragma unroll
        for (int j = 0; j < 4; ++j) { v[j] = *(const f32x4*)(xr + 4 * lane + 256 * j); s += (v[j][0] * v[j][0] + v[j][1] * v[j][1]) + (v[j][2] * v[j][2] + v[j][3] * v[j][3]); }
        const float rstd = 1.0f / sqrtf(wave_sum(s) * (1.0f / D) + EPS);
#pragma unroll
        for (int j = 0; j < 4; ++j) { const int c = 4 * lane + 256 * j; *(f32x4*)(out + (size_t)m * D + c) = (v[j] * rstd) * *(const f32x4*)(g + c); }
    }
}

__device__ __forceinline__ void pool_phase(const float* X, const float* g, const float* mods_l, bf16_t* Pq, LAS float* rs) {
    const int tid = opaque_tid(), lane = tid & 63, wave = __builtin_amdgcn_readfirstlane(tid >> 6);
    for (int ch = blockIdx.x; ch < MTOT / 16; ch += gridDim.x) {
        const int m0 = ch * 16; int s0, s1, mb;
        if (m0 < MLAT) { s0 = m0 & ~4095; s1 = s0 + 4096; mb = m0 >> 12; } else { s0 = MLAT + ((m0 - MLAT) & ~255); s1 = s0 + 256; mb = 4; }
        const int lo = max(m0 - 8, s0), hi = min(m0 + 24, s1);
        for (int r = lo + wave; r < hi; r += NWAVES) {
            const float* xr = X + (size_t)r * D; float s = 0.f;
#pragma unroll
            for (int j = 0; j < 4; ++j) { const f32x4 v = *(const f32x4*)(xr + 4 * lane + 256 * j); s += (v[0] * v[0] + v[1] * v[1]) + (v[2] * v[2] + v[3] * v[3]); }
            const float rstd = 1.0f / sqrtf(wave_sum(s) * (1.0f / D) + EPS);
            if (lane == 0) rs[r - lo] = rstd;
        }
        __syncthreads();
        const int c = 2 * tid, hw = 1 << (c >> 8);
        const f32x2 gv = *(const f32x2*)(g + c), scv = *(const f32x2*)(mods_l + (size_t)mb * NMOD + 1 * D + c);
        const f32x2 Gv = gv * (scv + 1.0f);
        int wl = max(m0 - hw, s0), wh = min(m0 + hw, s1);
        f32x2 sum = (f32x2){0.f, 0.f};
        for (int r = wl; r < wh; ++r) sum += *(const f32x2*)(X + (size_t)r * D + c) * rs[r - lo];
        for (int t = m0; t < m0 + 16; ++t) {
            if (t > m0) {
                const int nl = max(t - hw, s0), nh = min(t + hw, s1);
                if (nh > wh) { sum += *(const f32x2*)(X + (size_t)wh * D + c) * rs[wh - lo]; wh = nh; }
                if (nl > wl) { sum -= *(const f32x2*)(X + (size_t)wl * D + c) * rs[wl - lo]; wl = nl; }
            }
            const float inv = 1.0f / (float)(wh - wl);
            const f32x2 xc = *(const f32x2*)(X + (size_t)t * D + c) * rs[t - lo];
            const f32x2 p = (sum * inv - xc) * Gv;
            *(unsigned*)(Pq + (size_t)t * D + c) = cvt_pk_bf16(p[0], p[1]);
        }
        __syncthreads();
    }
}

__device__ __forceinline__ void conv_phase(const bf16_t* GB, const bf16_t* U, const float* cw, bf16_t* Z) {
    const int tid = opaque_tid();
    const long total = (long)MTOT * 128, nth = (long)gridDim.x * NTHREADS;
    for (long idx = (long)blockIdx.x * NTHREADS + tid; idx < total; idx += nth) {
        const int m = (int)(idx >> 7), c8 = (int)(idx & 127) * 8;
        const int pos = m < MLAT ? (m & 4095) : ((m - MLAT) & 255), len = m < MLAT ? 4096 : 256;
        const u32x4 zero = (u32x4){0u, 0u, 0u, 0u};
        const u32x4 g4 = *(const u32x4*)(GB + (size_t)m * D + c8), u0 = *(const u32x4*)(U + (size_t)m * D + c8);
        const u32x4 um = pos > 0 ? *(const u32x4*)(U + (size_t)(m - 1) * D + c8) : zero;
        const u32x4 up = pos < len - 1 ? *(const u32x4*)(U + (size_t)(m + 1) * D + c8) : zero;
        float o[8];
#pragma unroll
        for (int e = 0; e < 4; ++e) {
            const int c = c8 + 2 * e;
            const f32x2 w0 = *(const f32x2*)(cw + c), w1 = *(const f32x2*)(cw + D + c), w2 = *(const f32x2*)(cw + 2 * D + c);
            o[2 * e] = bf_lo(g4[e]) * (bf_lo(um[e]) * w0[0] + bf_lo(u0[e]) * w1[0] + bf_lo(up[e]) * w2[0]);
            o[2 * e + 1] = bf_hi(g4[e]) * (bf_hi(um[e]) * w0[1] + bf_hi(u0[e]) * w1[1] + bf_hi(up[e]) * w2[1]);
        }
        u32x4 w; w.x = cvt_pk_bf16(o[0], o[1]); w.y = cvt_pk_bf16(o[2], o[3]); w.z = cvt_pk_bf16(o[4], o[5]); w.w = cvt_pk_bf16(o[6], o[7]);
        *(u32x4*)(Z + (size_t)m * D + c8) = w;
    }
}

__device__ __forceinline__ void attn_naive_phase(const bf16_t* Q, const bf16_t* Kb, const bf16_t* VT, bf16_t* O, const float* rpb, LAS float* pl_all, int nrows) {
    const int tid = opaque_tid(), lane = tid & 63, wave = __builtin_amdgcn_readfirstlane(tid >> 6);
    const int gw = blockIdx.x * NWAVES + wave, NGW = gridDim.x * NWAVES;
    LAS float* pl = pl_all + wave * 384;
    for (long task = gw; task < (long)nrows * NH; task += NGW) {
        const int m = (int)(task >> 4), h = (int)(task & 15);
        const bool lat = m < MLAT; const int b = lat ? (m >> 12) : ((m - MLAT) >> 8);
        int r = 0, qc = 0, start = 0, cs = 0;
        if (lat) { const int t = m & 4095; r = t >> 6; qc = t & 63; start = min(max(r - 4, 0), 56); cs = min(max(qc - 8, 0), 48); }
        const int ctxbase = MLAT + b * 256;
        u32x4 qv[8];
#pragma unroll
        for (int i = 0; i < 8; ++i) qv[i] = *(const u32x4*)(Q + (size_t)m * D + h * 64 + 8 * i);
        float s[6];
#pragma unroll
        for (int i = 0; i < 6; ++i) {
            int tok = 0; float bias = 0.f; bool valid = true;
            if (i < 2) {
                if (!lat) valid = false;
                else { const int j = lane + 64 * i, kr = start + (j >> 4), kc = cs + (j & 15); tok = b * 4096 + kr * 64 + kc;
                    bias = rpb[(h * 15 + (kr - r + 7)) * 31 + (kc - qc + 15)] * LOG2E; }
            } else tok = ctxbase + lane + 64 * (i - 2);
            float dot = 0.f;
            if (valid) {
                const bf16_t* kp = Kb + (size_t)tok * D + h * 64;
#pragma unroll
                for (int ii = 0; ii < 8; ++ii) { const u32x4 kv = *(const u32x4*)(kp + 8 * ii);
#pragma unroll
                    for (int e = 0; e < 4; ++e) dot += bf_lo(qv[ii][e]) * bf_lo(kv[e]) + bf_hi(qv[ii][e]) * bf_hi(kv[e]); }
                s[i] = dot + bias;
            } else s[i] = -INFINITY;
        }
        float mx = s[0];
#pragma unroll
        for (int i = 1; i < 6; ++i) mx = fmaxf(mx, s[i]);
        mx = wave_max(mx);
        float sum = 0.f;
#pragma unroll
        for (int i = 0; i < 6; ++i) { const float p = exp2f(s[i] - mx); sum += p; pl[lane + 64 * i] = p; }
        sum = wave_sum(sum);
        __builtin_amdgcn_wave_barrier();
        asm volatile("s_waitcnt lgkmcnt(0)" ::: "memory");
        const bf16_t* vrow = VT + (size_t)(h * 64 + lane) * MTOT;
        float o = 0.f;
        if (lat) {
            for (int j = 0; j < 128; ++j) { const int tok = b * 4096 + (start + (j >> 4)) * 64 + cs + (j & 15); o += pl[j] * bf2f(vrow[tok]); }
        }
        for (int l8 = 0; l8 < 32; ++l8) {
            const u32x4 vv = *(const u32x4*)(vrow + ctxbase + 8 * l8);
#pragma unroll
            for (int e = 0; e < 4; ++e) o += pl[128 + 8 * l8 + 2 * e] * bf_lo(vv[e]) + pl[128 + 8 * l8 + 2 * e + 1] * bf_hi(vv[e]);
        }
        const float res = o / sum;
        O[(size_t)m * D + h * 64 + lane] = (bf16_t)(cvt_pk_bf16(res, 0.f) & 0xffffu);
        __builtin_amdgcn_wave_barrier();
        asm volatile("s_waitcnt lgkmcnt(0)" ::: "memory");
    }
}

__global__ void __launch_bounds__(NTHREADS, 2) mk_fwd(Args P) {
    extern __shared__ __attribute__((aligned(16))) unsigned char lds_raw[];
    LAS unsigned char* lds = (LAS unsigned char*)lds_raw;
    cg::grid_group grid = cg::this_grid();
    const int G = gridDim.x, bx = blockIdx.x;
    unsigned char* ws = P.ws;
    float* mods = (float*)(ws + WS_MODS);
    float* X = (float*)(ws + WS_X);
    bf16_t* H = (bf16_t*)(ws + WS_H);
    bf16_t* Qb = (bf16_t*)(ws + WS_Q); bf16_t* Kb = (bf16_t*)(ws + WS_K); bf16_t* VT = (bf16_t*)(ws + WS_VT); bf16_t* Ob = (bf16_t*)(ws + WS_O);
    bf16_t* Gb = (bf16_t*)(ws + WS_G);
    constexpr size_t TS1024 = (size_t)256 * 1024 * 2;

    prologue_phase(P, lds);
    grid.sync();

    for (int layer = 0; layer < NLAYER; ++layer) {
        const int kind = layer % 3, j = layer / 3;
        const bool lastl = (layer == NLAYER - 1);
        const int nrows = lastl ? MLAT : MTOT;
        const float* mods_l = mods + (size_t)layer * 5 * NMOD;
        const float* xin_lat = layer == 0 ? P.x : X;
        const float* xin_ctx = layer == 0 ? P.ctx : X + (size_t)MLAT * D;

        if (kind == 0) {
            norm_phase(xin_lat, xin_ctx, P.norm_mix_g + layer * D, mods_l, 0, 1, H, MTOT);
            grid.sync();
            {
                const bf16_t* Wt = (const bf16_t*)(ws + WS_WQKV) + (size_t)j * 3 * D * D;
                pg8::Sched S; S.init1(H, TS1024, Wt, TS1024, MTOT / 256, 8, G, bx);
                S.add2(Wt + (size_t)2 * D * D, TS1024, H, TS1024, 4, MTOT / 256);
                pg8::EpiQKV E{Qb, Kb, VT};
                pg8::gemm_phase<pg8::EpiQKV>(lds, D, D, D, S, E);
            }
            grid.sync();
            attn_naive_phase(Qb, Kb, VT, Ob, P.na_rpb + (size_t)j * NH * 15 * 31, (LAS float*)lds, nrows);
            grid.sync();
            {
                const bf16_t* Wt = (const bf16_t*)(ws + WS_WO) + (size_t)j * D * D;
                pg8::Sched S; S.init1(Ob, TS1024, Wt, TS1024, nrows / 256, 4, G, bx);
                pg8::EpiRes E{xin_lat, xin_ctx, X, mods_l + 2 * D, nullptr};
                pg8::gemm_phase<pg8::EpiRes>(lds, D, D, D, S, E);
            }
            grid.sync();
        } else if (kind == 1) {
            norm_phase(xin_lat, xin_ctx, P.norm_mix_g + layer * D, mods_l, 0, 1, H, MTOT);
            grid.sync();
            {
                const bf16_t* Wt = (const bf16_t*)(ws + WS_WSCIN);
                pg8::Sched S; S.init1(H, TS1024, Wt, TS1024, MTOT / 256, 12, G, bx);
                pg8::EpiSCin E{Qb, Kb};
                pg8::gemm_phase<pg8::EpiSCin>(lds, D, D, D, S, E);
            }
            grid.sync();
            conv_phase(Qb, Kb, P.sc_conv_w + (size_t)j * 3 * D, Ob);
            grid.sync();
            {
                const bf16_t* Wt = (const bf16_t*)(ws + WS_WSCOUT);
                pg8::Sched S; S.init1(Ob, TS1024, Wt, TS1024, nrows / 256, 4, G, bx);
                pg8::EpiRes E{xin_lat, xin_ctx, X, mods_l + 2 * D, nullptr};
                pg8::gemm_phase<pg8::EpiRes>(lds, D, D, D, S, E);
            }
            grid.sync();
        } else {
            pool_phase(X, P.norm_mix_g + layer * D, mods_l, H, (LAS float*)lds);
            grid.sync();
            {
                const bf16_t* Wt = (const bf16_t*)(ws + WS_WPOOL);
                pg8::Sched S; S.init1(H, TS1024, Wt, (size_t)256 * 256 * 2, nrows / 256, 4, G, bx); S.apn = 512;
                pg8::EpiRes E{xin_lat, xin_ctx, X, mods_l + 2 * D, P.pool_scale + (size_t)j * D};
                pg8::gemm_phase<pg8::EpiRes>(lds, 256, D, 256, S, E);
            }
            grid.sync();
        }
        norm_phase(X, X + (size_t)MLAT * D, P.norm_ffn_g + layer * D, mods_l, 3, 4, H, nrows);
        grid.sync();
        {
            const bf16_t* Wt = (const bf16_t*)(ws + WS_W13) + (size_t)layer * 2 * FF * D;
            pg8::Sched S; S.init1(H, TS1024, Wt, TS1024, nrows / 256, 2 * FF / 256, G, bx);
            pg8::EpiSwi E{Gb};
            pg8::gemm_phase<pg8::EpiSwi>(lds, D, D, D, S, E);
        }
        grid.sync();
        {
            const bf16_t* Wt = (const bf16_t*)(ws + WS_W2) + (size_t)layer * D * FF;
            pg8::Sched S; S.init1(Gb, (size_t)256 * FF * 2, Wt, (size_t)256 * FF * 2, nrows / 256, 4, G, bx);
            pg8::EpiRes E{X, X + (size_t)MLAT * D, X, mods_l + 5 * D, nullptr};
            pg8::gemm_phase<pg8::EpiRes>(lds, FF, FF, FF, S, E);
        }
        grid.sync();
    }
    final_norm_phase(X, P.final_g, P.out);
}

extern "C" void kernel_launch(void* const* d_in, const int* in_sizes, int n_in, void* d_out, int out_size, void* d_ws, size_t ws_size, hipStream_t stream) {
    static int grid = 0;
    if (grid == 0) {
        if (n_in != 20 || ws_size < WS_END) { fprintf(stderr, "kernel_launch: unexpected n_in %d / ws_size %zu\n", n_in, ws_size); grid = -1; return; }
        int dev = 0, cus = 0, per_cu = 0;
        hipGetDevice(&dev);
        hipDeviceGetAttribute(&cus, hipDeviceAttributeMultiprocessorCount, dev);
        if (hipFuncSetAttribute((const void*)mk_fwd, hipFuncAttributeMaxDynamicSharedMemorySize, LDS_BYTES) != hipSuccess) { fprintf(stderr, "kernel_launch: hipFuncSetAttribute failed\n"); }
        if (hipOccupancyMaxActiveBlocksPerMultiprocessor(&per_cu, (const void*)mk_fwd, NTHREADS, LDS_BYTES) != hipSuccess || per_cu < 1) { fprintf(stderr, "kernel_launch: occupancy query says %d\n", per_cu); per_cu = 1; }
        (void)hipGetLastError();
        grid = cus * 1;
        if (grid <= 0) grid = 256;
    }
    if (grid < 0) return;
    Args a{};
    const float** f = (const float**)&a;
    for (int i = 0; i < 20; ++i) f[i] = (const float*)d_in[i];
    a.out = (float*)d_out; a.ws = (unsigned char*)d_ws;
    void* args[] = {&a};
    hipError_t e = hipLaunchCooperativeKernel((const void*)mk_fwd, dim3(grid), dim3(NTHREADS), args, LDS_BYTES, stream);
    if (e != hipSuccess) fprintf(stderr, "cooperative launch failed: %s (grid %d)\n", hipGetErrorString(e), grid);
}
```

```cpp
#include <hip/hip_runtime.h>
#include <hip/hip_cooperative_groups.h>
#include <cstdio>
#include <cstdint>
namespace cg = cooperative_groups;

#define LAS __attribute__((address_space(3)))
typedef unsigned short bf16_t;
typedef short bf16x8 __attribute__((ext_vector_type(8)));
typedef float f32x4 __attribute__((ext_vector_type(4)));
typedef float f32x2 __attribute__((ext_vector_type(2)));
typedef unsigned u32x4 __attribute__((ext_vector_type(4)));
typedef unsigned u32x2 __attribute__((ext_vector_type(2)));

constexpr int D = 1024, NB = 4, SEQ = 4096, CTXL = 256, NLAYER = 4, FF = 2816, NH = 16, HD = 64;
constexpr int MLAT = NB * SEQ, MCTX = NB * CTXL, MTOT = MLAT + MCTX;
constexpr int NMOD = 6 * D;
constexpr float EPS = 1e-6f;
constexpr float LOG2E = 1.4426950408889634f;
constexpr float QSCALE = 0.125f * LOG2E;

constexpr size_t MiB = 1u << 20;
constexpr size_t WS_MODS = 0;
constexpr size_t WS_WQKV = 1 * MiB;
constexpr size_t WS_WO = 13 * MiB;
constexpr size_t WS_WSCIN = 17 * MiB;
constexpr size_t WS_WSCOUT = 23 * MiB;
constexpr size_t WS_WPOOL = 25 * MiB;
constexpr size_t WS_W13 = 26 * MiB;
constexpr size_t WS_W2 = 70 * MiB;
constexpr size_t WS_X = 92 * MiB;
constexpr size_t WS_H = 160 * MiB;
constexpr size_t WS_Q = 194 * MiB;
constexpr size_t WS_K = 228 * MiB;
constexpr size_t WS_VT = 262 * MiB;
constexpr size_t WS_O = 296 * MiB;
constexpr size_t WS_G = 194 * MiB;
constexpr size_t WS_END = 330 * MiB;
static_assert(WS_G + (size_t)MTOT * FF * 2 <= WS_O, "G overlay");

constexpr int LDS_BYTES = 147456;
constexpr int NWAVES = 8, NTHREADS = 512;

__device__ __forceinline__ int opaque_tid() { int t = threadIdx.x; asm volatile("" : "+v"(t)); return t; }
__device__ __forceinline__ unsigned cvt_pk_bf16(float lo, float hi) { unsigned r; asm volatile("v_cvt_pk_bf16_f32 %0, %1, %2" : "=v"(r) : "v"(lo), "v"(hi)); return r; }
__device__ __forceinline__ float bf_lo(unsigned w) { return __uint_as_float(w << 16); }
__device__ __forceinline__ float bf_hi(unsigned w) { return __uint_as_float(w & 0xffff0000u); }
__device__ __forceinline__ float bf2f(bf16_t v) { return __uint_as_float(((unsigned)v) << 16); }
__device__ __forceinline__ float silu_f(float x) { return x * __builtin_amdgcn_rcpf(1.0f + __expf(-x)); }
__device__ __forceinline__ float wave_sum(float v) {
#pragma unroll
    for (int o = 1; o < 64; o <<= 1) v += __shfl_xor(v, o);
    return v;
}
__device__ __forceinline__ float wave_max(float v) {
#pragma unroll
    for (int o = 1; o < 64; o <<= 1) v = fmaxf(v, __shfl_xor(v, o));
    return v;
}

namespace pg8 {
constexpr int BM = 256, BK = 64, HALF = 128, HTB = HALF * BK * 2, STAGE_BYTES = 8 * HTB, NXCD = 8, WGM = 8;
__host__ __device__ __forceinline__ int lds_byte(int r, int c) { const int st = (r >> 4) * 2 + (c >> 5), rr = r & 15, cc = c & 31, ob = rr * 64 + cc * 2; return st * 1024 + (ob ^ (((ob >> 9) & 1) << 5)); }
__host__ __device__ __forceinline__ void stage_rc(int b, int& R, int& C) { const int st = b / 1024, sb = b % 1024, swz = sb ^ (((sb >> 9) & 1) << 5); R = (st >> 1) * 16 + swz / 64; C = (st & 1) * 32 + (swz % 64) / 2; }
__host__ __device__ __forceinline__ int perm32(int rho) { const int n = rho >> 4, i = rho & 15; return 8 * (i >> 2) + 4 * n + (i & 3); }

struct Unit { const char* a; const char* b; int pm, pn, fam; };

struct Sched {
    const char* A1; const char* B1; size_t tsA1, tsB1, apn; int nM1, nN1, nwg1;
    const char* A2; const char* B2; size_t tsA2, tsB2; int nM2, nN2;
    int nwg, G, c;
    __device__ void init1(const void* A, size_t tsA, const void* B, size_t tsB, int nM, int nN, int G_, int c_) {
        A1 = (const char*)A; B1 = (const char*)B; tsA1 = tsA; tsB1 = tsB; apn = 0; nM1 = nM; nN1 = nN; nwg1 = nM * nN;
        A2 = nullptr; B2 = nullptr; tsA2 = 0; tsB2 = 0; nM2 = 0; nN2 = 0; nwg = nwg1; G = G_; c = c_;
    }
    __device__ void add2(const void* A, size_t tsA, const void* B, size_t tsB, int nM, int nN) {
        A2 = (const char*)A; B2 = (const char*)B; tsA2 = tsA; tsB2 = tsB; nM2 = nM; nN2 = nN; nwg = nwg1 + nM * nN;
    }
    __device__ bool next(int i, Unit& u) const {
        const long L = (long)i * G + c; if (L >= nwg) return false;
        int wgid = (int)L; { const int q = nwg / NXCD, r = nwg % NXCD, xcd = wgid % NXCD, off = wgid / NXCD; wgid = (xcd < r ? xcd * (q + 1) : r * (q + 1) + (xcd - r) * q) + off; }
        if (wgid < nwg1) {
            const int nig = WGM * nN1, gid = wgid / nig, fm = gid * WGM, gsz = (nM1 - fm) < WGM ? (nM1 - fm) : WGM;
            u.pm = fm + ((wgid % nig) % gsz); u.pn = (wgid % nig) / gsz; u.fam = 0;
            u.a = A1 + (size_t)u.pm * tsA1 + (size_t)u.pn * apn; u.b = B1 + (size_t)u.pn * tsB1;
        } else {
            const int w2 = wgid - nwg1; u.pm = w2 % nM2; u.pn = w2 / nM2; u.fam = 1;
            u.a = A2 + (size_t)u.pm * tsA2; u.b = B2 + (size_t)u.pn * tsB2;
        }
        return true;
    }
};

typedef f32x4 Acc[2][2][4][2];

__device__ __forceinline__ void store_plain(const Acc& acc, bf16_t* base, size_t ldc, int row0, int col0, float sc, int wr, int wc, int fr, int fq) {
#pragma unroll
    for (int ai = 0; ai < 2; ++ai)
#pragma unroll
        for (int m = 0; m < 4; ++m) {
            bf16_t* rowp = base + (size_t)(row0 + wr * 64 + fr + ai * HALF + m * 16) * ldc + col0 + wc * 32 + 8 * fq;
#pragma unroll
            for (int bj = 0; bj < 2; ++bj) {
                const f32x4 v0 = acc[ai][bj][m][0] * sc, v1 = acc[ai][bj][m][1] * sc;
                u32x4 w; w.x = cvt_pk_bf16(v0[0], v0[1]); w.y = cvt_pk_bf16(v0[2], v0[3]); w.z = cvt_pk_bf16(v1[0], v1[1]); w.w = cvt_pk_bf16(v1[2], v1[3]);
                *(u32x4*)(rowp + bj * HALF) = w;
            }
        }
}
template <int ACT>
__device__ __forceinline__ void store_pair(const Acc& acc, bf16_t* base, size_t ldc, int row0, int col0, int wr, int wc, int fr, int fq) {
#pragma unroll
    for (int ai = 0; ai < 2; ++ai)
#pragma unroll
        for (int m = 0; m < 4; ++m) {
            bf16_t* rowp = base + (size_t)(row0 + wr * 64 + fr + ai * HALF + m * 16) * ldc + col0 + wc * 32 + 8 * fq;
            float o[8];
#pragma unroll
            for (int n = 0; n < 2; ++n)
#pragma unroll
                for (int e = 0; e < 4; ++e) { const float a = acc[ai][0][m][n][e], b = acc[ai][1][m][n][e]; o[n * 4 + e] = (ACT == 1 ? silu_f(a) : a) * b; }
            u32x4 w; w.x = cvt_pk_bf16(o[0], o[1]); w.y = cvt_pk_bf16(o[2], o[3]); w.z = cvt_pk_bf16(o[4], o[5]); w.w = cvt_pk_bf16(o[6], o[7]);
            *(u32x4*)rowp = w;
        }
}

struct EpiQKV {
    static constexpr bool PERM = true;
    bf16_t *Q, *K, *VT;
    __device__ __forceinline__ void operator()(const Acc& acc, const Unit& u, int wr, int wc, int fr, int fq) const {
        if (u.fam == 0) {
            if (u.pn < 4) store_plain(acc, Q, D, u.pm * BM, u.pn * BM, QSCALE, wr, wc, fr, fq);
            else store_plain(acc, K, D, u.pm * BM, (u.pn - 4) * BM, 1.0f, wr, wc, fr, fq);
        } else store_plain(acc, VT, MTOT, u.pm * BM, u.pn * BM, 1.0f, wr, wc, fr, fq);
    }
};
struct EpiSCin {
    static constexpr bool PERM = true;
    bf16_t *GB, *U;
    __device__ __forceinline__ void operator()(const Acc& acc, const Unit& u, int wr, int wc, int fr, int fq) const {
        if (u.pn < 4) store_plain(acc, GB, D, u.pm * BM, u.pn * BM, 1.0f, wr, wc, fr, fq);
        else store_pair<0>(acc, U, D, u.pm * BM, (u.pn - 4) * HALF, wr, wc, fr, fq);
    }
};
struct EpiSwi {
    static constexpr bool PERM = true;
    bf16_t* Gb;
    __device__ __forceinline__ void operator()(const Acc& acc, const Unit& u, int wr, int wc, int fr, int fq) const {
        store_pair<1>(acc, Gb, FF, u.pm * BM, u.pn * HALF, wr, wc, fr, fq);
    }
};
struct EpiRes {
    static constexpr bool PERM = false;
    const float* res_lat; const float* res_ctx; float* X; const float* gate;   const float* cscale;
    __device__ __forceinline__ void operator()(const Acc& acc, const Unit& u, int wr, int wc, int fr, int fq) const {
        const int row0 = u.pm * BM, colb = u.pn * BM + wc * 32 + 4 * fq;
        const bool lat = row0 < MLAT; const int mb = lat ? (row0 >> 12) : 4;
        const float* gp = gate + (size_t)mb * NMOD;
        const float* rbase = lat ? res_lat : res_ctx - (size_t)MLAT * D;
        f32x4 gv[2][2];
#pragma unroll
        for (int bj = 0; bj < 2; ++bj)
#pragma unroll
            for (int n = 0; n < 2; ++n) { const int c = colb + bj * HALF + n * 16; f32x4 g = *(const f32x4*)(gp + c); if (cscale) g = g * *(const f32x4*)(cscale + c); gv[bj][n] = g; }
#pragma unroll
        for (int ai = 0; ai < 2; ++ai)
#pragma unroll
            for (int m = 0; m < 4; ++m) {
                const size_t off = (size_t)(row0 + wr * 64 + fr + ai * HALF + m * 16) * D;
#pragma unroll
                for (int bj = 0; bj < 2; ++bj)
#pragma unroll
                    for (int n = 0; n < 2; ++n) { const int c = colb + bj * HALF + n * 16; const f32x4 r = *(const f32x4*)(rbase + off + c); *(f32x4*)(X + off + c) = r + gv[bj][n] * acc[ai][bj][m][n]; }
                asm volatile("" ::: "memory");
            }
    }
};

template <class Epi>
__device__ __forceinline__ void gemm_phase(LAS unsigned char* lds, const int K, const int lda, const int ldb, const Sched& S, const Epi& E) {
    const int tid = opaque_tid(), wid = __builtin_amdgcn_readfirstlane(tid >> 6), lane = tid & 63, wr = wid >> 2, wc = wid & 3, fr = lane & 15, fq = lane >> 4;
    const int nt = K / BK;
    unsigned voffA[2], voffB[2];
#pragma unroll
    for (int i = 0; i < 2; ++i) { int R, C; stage_rc(tid * 16 + i * 8192, R, C); const int Rb = Epi::PERM ? ((R & ~31) + perm32(R & 31)) : R;
        voffA[i] = (unsigned)(R * lda + C) * 2u; voffB[i] = (unsigned)(Rb * ldb + C) * 2u; }
    const size_t kstep = (size_t)(BK * 2);
    const size_t hsA = (size_t)HALF * lda * 2, hsB = (size_t)HALF * ldb * 2;
    const unsigned ldsw = (unsigned)wid * 1024u;
    const int aoff = lds_byte(wr * 64 + fr, fq * 8), boff = lds_byte(wc * 32 + fr, fq * 8);
#define PG8_SA(b, h) (((b) * 2 + (h)) * HTB)
#define PG8_SB(b, h) ((4 + (b) * 2 + (h)) * HTB)
#define PG8_STAGE(bufoff, gbase, voff) do { _Pragma("unroll") for (int _i = 0; _i < 2; ++_i) \
        __builtin_amdgcn_global_load_lds((const unsigned*)((const char*)(gbase) + (voff)[_i]), (LAS unsigned*)(lds + (bufoff) + ldsw + _i * 8192), 16, 0, 0); } while (0)
#define PG8_LDA(dst, b, h) do { _Pragma("unroll") for (int m = 0; m < 4; ++m) _Pragma("unroll") for (int k = 0; k < 2; ++k) dst[m][k] = *(const LAS bf16x8*)(lds + PG8_SA(b, h) + aoff + m * 2048 + k * 1024); } while (0)
#define PG8_LDB(dst, b, h) do { _Pragma("unroll") for (int n = 0; n < 2; ++n) _Pragma("unroll") for (int k = 0; k < 2; ++k) dst[n][k] = *(const LAS bf16x8*)(lds + PG8_SB(b, h) + boff + n * 2048 + k * 1024); } while (0)
#define PG8_MMA(ai, bj, At, Bt) do { __builtin_amdgcn_s_setprio(1); _Pragma("unroll") for (int m = 0; m < 4; ++m) _Pragma("unroll") for (int n = 0; n < 2; ++n) _Pragma("unroll") for (int k = 0; k < 2; ++k) \
        acc[ai][bj][m][n] = __builtin_amdgcn_mfma_f32_16x16x32_bf16(Bt[n][k], At[m][k], acc[ai][bj][m][n], 0, 0, 0); __builtin_amdgcn_s_setprio(0); } while (0)
#define PG8_WAIT_V(n) asm volatile("s_waitcnt vmcnt(" #n ")" ::: "memory")
#define PG8_WAIT_L(n) asm volatile("s_waitcnt lgkmcnt(" #n ")" ::: "memory")
#define PG8_BAR __builtin_amdgcn_s_barrier()
#define PG8_SCHED __builtin_amdgcn_sched_barrier(0)
    Unit cur, nxt; int ui = 0;
    if (!S.next(0, cur)) return;
    Acc acc;
#pragma unroll
    for (int a = 0; a < 2; ++a)
#pragma unroll
        for (int b = 0; b < 2; ++b)
#pragma unroll
            for (int m = 0; m < 4; ++m)
#pragma unroll
                for (int n = 0; n < 2; ++n) acc[a][b][m][n] = (f32x4){0.f, 0.f, 0.f, 0.f};
    bf16x8 At[4][2], B0[2][2], B1[2][2];
    const char* cA = cur.a; const char* cB = cur.b;
    PG8_STAGE(PG8_SB(0, 0), cB, voffB); PG8_STAGE(PG8_SB(0, 1), cB + hsB, voffB); PG8_STAGE(PG8_SA(0, 0), cA, voffA); PG8_STAGE(PG8_SA(0, 1), cA + hsA, voffA);
    if (wr == 1) PG8_BAR;
    PG8_WAIT_V(2); PG8_BAR;
    PG8_STAGE(PG8_SB(1, 0), cB + kstep, voffB); PG8_STAGE(PG8_SA(1, 0), cA + kstep, voffA); PG8_STAGE(PG8_SB(1, 1), cB + hsB + kstep, voffB);
    PG8_WAIT_V(6); PG8_BAR;
    for (;;) {
        const bool has_next = S.next(ui + 1, nxt);
        const char* nA = has_next ? nxt.a : cA; const char* nB = has_next ? nxt.b : cB;
        for (int t = 0; t < nt; t += 2) {
            const bool last = (t == nt - 2);
            const char* a1 = cA + (size_t)(t + 1) * kstep;
            const char* a2 = last ? nA : cA + (size_t)(t + 2) * kstep; const char* b2 = last ? nB : cB + (size_t)(t + 2) * kstep;
            const char* a3 = a2 + kstep; const char* b3 = b2 + kstep;
            PG8_LDB(B0, 0, 0); PG8_LDB(B1, 0, 1); PG8_SCHED; PG8_LDA(At, 0, 0); PG8_STAGE(PG8_SA(1, 1), a1 + hsA, voffA);
            PG8_WAIT_V(8); PG8_WAIT_L(0); PG8_BAR; PG8_MMA(0, 0, At, B0); PG8_MMA(0, 1, At, B1); PG8_BAR; PG8_SCHED;
            PG8_LDA(At, 0, 1); PG8_STAGE(PG8_SB(0, 0), b2, voffB); PG8_STAGE(PG8_SB(0, 1), b2 + hsB, voffB); PG8_STAGE(PG8_SA(0, 0), a2, voffA);
            PG8_WAIT_V(8); PG8_WAIT_L(0); PG8_BAR; PG8_MMA(1, 0, At, B0); PG8_MMA(1, 1, At, B1); PG8_BAR; PG8_SCHED;
            PG8_LDB(B0, 1, 0); PG8_LDB(B1, 1, 1); PG8_SCHED; PG8_LDA(At, 1, 0); PG8_STAGE(PG8_SA(0, 1), a2 + hsA, voffA);
            PG8_WAIT_V(8); PG8_WAIT_L(0); PG8_BAR; PG8_MMA(0, 0, At, B0); PG8_MMA(0, 1, At, B1); PG8_BAR; PG8_SCHED;
            PG8_LDA(At, 1, 1); PG8_STAGE(PG8_SB(1, 0), b3, voffB); PG8_STAGE(PG8_SB(1, 1), b3 + hsB, voffB); PG8_STAGE(PG8_SA(1, 0), a3, voffA);
            PG8_WAIT_V(8); PG8_WAIT_L(0); PG8_BAR; PG8_MMA(1, 0, At, B0); PG8_MMA(1, 1, At, B1); PG8_BAR; PG8_SCHED;
        }
        if (wr == 0) PG8_BAR;
        E(acc, cur, wr, wc, fr, fq);
        if (!has_next) break;
#pragma unroll
        for (int a = 0; a < 2; ++a)
#pragma unroll
            for (int b = 0; b < 2; ++b)
#pragma unroll
                for (int m = 0; m < 4; ++m)
#pragma unroll
                    for (int n = 0; n < 2; ++n) acc[a][b][m][n] = (f32x4){0.f, 0.f, 0.f, 0.f};
        cur = nxt; cA = nA; cB = nB; ++ui;
        if (wr == 1) PG8_BAR;
    }
    PG8_WAIT_V(0);
    PG8_BAR;
#undef PG8_SA
#undef PG8_SB
#undef PG8_STAGE
#undef PG8_LDA
#undef PG8_LDB
#undef PG8_MMA
#undef PG8_WAIT_V
#undef PG8_WAIT_L
#undef PG8_BAR
#undef PG8_SCHED
}
}

struct Args {
    const float *x, *c, *ctx, *c_ctx, *adaln_w, *adaln_b, *norm_mix_g, *norm_ffn_g, *ffn_w1, *ffn_w3, *ffn_w2;
    const float *na_w_qkv, *na_w_o, *na_rpb, *sc_w_in, *sc_conv_w, *sc_w_out, *pool_w, *pool_scale, *final_g;
    float* out; unsigned char* ws;
};

__device__ __forceinline__ void transpose_item(const float* W, int N, int k0, int n0, bf16_t* WT, int ldk, int row_base, LAS float* scr, int lane) {
#pragma unroll 8
    for (int i = 0; i < 32; ++i) { const int kk = 2 * i + (lane >> 5); scr[kk * 33 + (lane & 31)] = W[(size_t)(k0 + kk) * N + n0 + (lane & 31)]; }
    asm volatile("s_waitcnt lgkmcnt(0)" ::: "memory");
    const int c = lane & 7;
#pragma unroll
    for (int j = 0; j < 4; ++j) { const int n = (lane >> 3) + 8 * j; const LAS float* s = scr + (8 * c) * 33 + n;
        u32x4 o; o.x = cvt_pk_bf16(s[0 * 33], s[1 * 33]); o.y = cvt_pk_bf16(s[2 * 33], s[3 * 33]); o.z = cvt_pk_bf16(s[4 * 33], s[5 * 33]); o.w = cvt_pk_bf16(s[6 * 33], s[7 * 33]);
        *(u32x4*)(WT + (size_t)(row_base + n) * ldk + k0 + 8 * c) = o; }
    asm volatile("s_waitcnt lgkmcnt(0)" ::: "memory");
}

__device__ __forceinline__ void prologue_phase(const Args& P, LAS unsigned char* lds) {
    const int tid = opaque_tid(), lane = tid & 63, wave = __builtin_amdgcn_readfirstlane(tid >> 6);
    unsigned char* ws = P.ws;
    LAS float* S = (LAS float*)lds;
    LAS float* red = (LAS float*)(lds + 5 * 1024 * 4);
    for (int i = tid; i < 5 * D; i += NTHREADS) { const float v = i < 4 * D ? P.c[i] : P.c_ctx[i - 4 * D]; S[i] = v / (1.0f + __expf(-v)); }
    __syncthreads();
    float* mods = (float*)(ws + WS_MODS);
    for (int item = blockIdx.x; item < NLAYER * (NMOD / 32); item += gridDim.x) {
        const int layer = item / (NMOD / 32), c0 = (item % (NMOD / 32)) * 32;
        const int kk = lane >> 3, cgp = lane & 7;
        const float* W = P.adaln_w + (size_t)layer * D * NMOD + c0 + 4 * cgp;
        f32x4 acc[5];
#pragma unroll
        for (int b = 0; b < 5; ++b) acc[b] = (f32x4){0.f, 0.f, 0.f, 0.f};
#pragma unroll 4
        for (int i = 0; i < 16; ++i) {
            const int k = 128 * wave + 8 * i + kk;
            const f32x4 wv = *(const f32x4*)(W + (size_t)k * NMOD);
#pragma unroll
            for (int b = 0; b < 5; ++b) acc[b] += wv * S[b * D + k];
        }
#pragma unroll
        for (int b = 0; b < 5; ++b)
#pragma unroll
            for (int e = 0; e < 4; ++e) { float v = acc[b][e]; v += __shfl_xor(v, 8); v += __shfl_xor(v, 16); v += __shfl_xor(v, 32); acc[b][e] = v; }
        if (lane < 8) {
#pragma unroll
            for (int b = 0; b < 5; ++b)
#pragma unroll
                for (int e = 0; e < 4; ++e) red[(wave * 5 + b) * 32 + 4 * cgp + e] = acc[b][e];
        }
        __syncthreads();
        if (tid < 160) { const int b = tid >> 5, cc = tid & 31; float s = P.adaln_b[(size_t)layer * NMOD + c0 + cc];
#pragma unroll
            for (int w = 0; w < 8; ++w) s += red[(w * 5 + b) * 32 + cc];
            mods[((size_t)layer * 5 + b) * NMOD + c0 + cc] = s; }
        __syncthreads();
    }
    LAS float* scr = (LAS float*)(lds + wave * 16384);
    const int gw = blockIdx.x * NWAVES + wave, NGW = gridDim.x * NWAVES;
    constexpr int I_QKV = 16 * 96, I_WO = 16 * 32, I_POOL = 4 * 8, I_W1 = 16 * 88, I_W2 = 44 * 32;
    constexpr int T_QKV = 2 * I_QKV, T_WO = 2 * I_WO, T_SCIN = I_QKV, T_SCOUT = I_WO, T_POOL = 4 * I_POOL, T_W1 = 4 * I_W1, T_W3 = 4 * I_W1, T_W2 = 4 * I_W2;
    constexpr int NITEMS = T_QKV + T_WO + T_SCIN + T_SCOUT + T_POOL + T_W1 + T_W3 + T_W2;
    for (int it = gw; it < NITEMS; it += NGW) {
        int r = it;
        if (r < T_QKV) { const int l = r / I_QKV, q = r % I_QKV, kb = q / 96, nb = q % 96;
            transpose_item(P.na_w_qkv + (size_t)l * D * 3 * D, 3 * D, 64 * kb, 32 * nb, (bf16_t*)(ws + WS_WQKV) + (size_t)l * 3 * D * D, D, 32 * nb, scr, lane); continue; } r -= T_QKV;
        if (r < T_WO) { const int l = r / I_WO, q = r % I_WO, kb = q / 32, nb = q % 32;
            transpose_item(P.na_w_o + (size_t)l * D * D, D, 64 * kb, 32 * nb, (bf16_t*)(ws + WS_WO) + (size_t)l * D * D, D, 32 * nb, scr, lane); continue; } r -= T_WO;
        if (r < T_SCIN) { const int kb = r / 96, nb = r % 96, n0 = 32 * nb;
            int rb; if (n0 < D) rb = n0; else if (n0 < 2 * D) { const int j = n0 - D; rb = D + (j / 128) * 256 + (j % 128); } else { const int j = n0 - 2 * D; rb = D + (j / 128) * 256 + 128 + (j % 128); }
            transpose_item(P.sc_w_in, 3 * D, 64 * kb, n0, (bf16_t*)(ws + WS_WSCIN), D, rb, scr, lane); continue; } r -= T_SCIN;
        if (r < T_SCOUT) { const int kb = r / 32, nb = r % 32;
            transpose_item(P.sc_w_out, D, 64 * kb, 32 * nb, (bf16_t*)(ws + WS_WSCOUT), D, 32 * nb, scr, lane); continue; } r -= T_SCOUT;
        if (r < T_POOL) { const int g = r / I_POOL, q = r % I_POOL, kb = q / 8, nb = q % 8;
            transpose_item(P.pool_w + (size_t)g * 256 * 256, 256, 64 * kb, 32 * nb, (bf16_t*)(ws + WS_WPOOL) + (size_t)g * 256 * 256, 256, 32 * nb, scr, lane); continue; } r -= T_POOL;
        if (r < T_W1 + T_W3) { const int which = r / T_W1; r -= which * T_W1; const int l = r / I_W1, q = r % I_W1, kb = q / 88, nb = q % 88, n0 = 32 * nb;
            const float* src = (which ? P.ffn_w3 : P.ffn_w1) + (size_t)l * D * FF;
            transpose_item(src, FF, 64 * kb, n0, (bf16_t*)(ws + WS_W13) + (size_t)l * 2 * FF * D, D, (n0 / 128) * 256 + which * 128 + (n0 % 128), scr, lane); continue; } r -= T_W1 + T_W3;
        { const int l = r / I_W2, q = r % I_W2, kb = q / 32, nb = q % 32;
            transpose_item(P.ffn_w2 + (size_t)l * FF * D, D, 64 * kb, 32 * nb, (bf16_t*)(ws + WS_W2) + (size_t)l * D * FF, FF, 32 * nb, scr, lane); }
    }
}

__device__ __forceinline__ void norm_phase(const float* src_lat, const float* src_ctx, const float* g, const float* mods_l, int shift_i, int scale_i, bf16_t* H, int nrows) {
    const int tid = opaque_tid(), lane = tid & 63, wave = __builtin_amdgcn_readfirstlane(tid >> 6);
    const int gw = blockIdx.x * NWAVES + wave, NGW = gridDim.x * NWAVES;
    for (int m = gw; m < nrows; m += NGW) {
        const float* xr = m < MLAT ? src_lat + (size_t)m * D : src_ctx + (size_t)(m - MLAT) * D;
        const int mb = m < MLAT ? (m >> 12) : 4;
        const float* sh = mods_l + (size_t)mb * NMOD + shift_i * D; const float* sc = mods_l + (size_t)mb * NMOD + scale_i * D;
        f32x4 v[4]; float s = 0.f;
#pragma unroll
        for (int j = 0; j < 4; ++j) { v[j] = *(const f32x4*)(xr + 4 * lane + 256 * j); s += (v[j][0] * v[j][0] + v[j][1] * v[j][1]) + (v[j][2] * v[j][2] + v[j][3] * v[j][3]); }
        const float rstd = 1.0f / sqrtf(wave_sum(s) * (1.0f / D) + EPS);
#pragma unroll
        for (int j = 0; j < 4; ++j) { const int c = 4 * lane + 256 * j;
            const f32x4 gv = *(const f32x4*)(g + c), scv = *(const f32x4*)(sc + c), shv = *(const f32x4*)(sh + c);
            const f32x4 o = (v[j] * rstd) * gv * (scv + 1.0f) + shv;
            u32x2 w; w.x = cvt_pk_bf16(o[0], o[1]); w.y = cvt_pk_bf16(o[2], o[3]);
            *(u32x2*)(H + (size_t)m * D + c) = w; }
    }
}
__device__ __forceinline__ void final_norm_phase(const float* X, const float* g, float* out) {
    const int tid = opaque_tid(), lane = tid & 63, wave = __builtin_amdgcn_readfirstlane(tid >> 6);
    const int gw = blockIdx.x * NWAVES + wave, NGW = gridDim.x * NWAVES;
    for (int m = gw; m < MLAT; m += NGW) {
        const float* xr = X + (size_t)m * D;
        f32x4 v[4]; float s = 0.f;
#pragma unroll
        for (int j = 0; j < 4; ++j) { v[j] = *(const f32x4*)(xr + 4 * lane + 256 * j); s += (v[j][0] * v[j][0] + v[j][1] * v[j][1]) + (v[j][2] * v[j][2] + v[j][3] * v[j][3]); }
        const float rstd = 1.0f / sqrtf(wave_sum(s) * (1.0f / D) + EPS);
#pragma unroll
        for (int j = 0; j < 4; ++j) { const int c = 4 * lane + 256 * j; *(f32x4*)(out + (size_t)m * D + c) = (v[j] * rstd) * *(const f32x4*)(g + c); }
    }
}

__device__ __forceinline__ void pool_phase(const float* X, const float* g, const float* mods_l, bf16_t* Pq, LAS float* rs) {
    const int tid = opaque_tid(), lane = tid & 63, wave = __builtin_amdgcn_readfirstlane(tid >> 6);
    for (int ch = blockIdx.x; ch < MTOT / 16; ch += gridDim.x) {
        const int m0 = ch * 16; int s0, s1, mb;
        if (m0 < MLAT) { s0 = m0 & ~4095; s1 = s0 + 4096; mb = m0 >> 12; } else { s0 = MLAT + ((m0 - MLAT) & ~255); s1 = s0 + 256; mb = 4; }
        const int lo = max(m0 - 8, s0), hi = min(m0 + 24, s1);
        for (int r = lo + wave; r < hi; r += NWAVES) {
            const float* xr = X + (size_t)r * D; float s = 0.f;
#pragma unroll
            for (int j = 0; j < 4; ++j) { const f32x4 v = *(const f32x4*)(xr + 4 * lane + 256 * j); s += (v[0] * v[0] + v[1] * v[1]) + (v[2] * v[2] + v[3] * v[3]); }
            const float rstd = 1.0f / sqrtf(wave_sum(s) * (1.0f / D) + EPS);
            if (lane == 0) rs[r - lo] = rstd;
        }
        __syncthreads();
        const int c = 2 * tid, hw = 1 << (c >> 8);
        const f32x2 gv = *(const f32x2*)(g + c), scv = *(const f32x2*)(mods_l + (size_t)mb * NMOD + 1 * D + c);
        const f32x2 Gv = gv * (scv + 1.0f);
        int wl = max(m0 - hw, s0), wh = min(m0 + hw, s1);
        f32x2 sum = (f32x2){0.f, 0.f};
        for (int r = wl; r < wh; ++r) sum += *(const f32x2*)(X + (size_t)r * D + c) * rs[r - lo];
        for (int t = m0; t < m0 + 16; ++t) {
            if (t > m0) {
                const int nl = max(t - hw, s0), nh = min(t + hw, s1);
                if (nh > wh) { sum += *(const f32x2*)(X + (size_t)wh * D + c) * rs[wh - lo]; wh = nh; }
                if (nl > wl) { sum -= *(const f32x2*)(X + (size_t)wl * D + c) * rs[wl - lo]; wl = nl; }
            }
            const float inv = 1.0f / (float)(wh - wl);
            const f32x2 xc = *(const f32x2*)(X + (size_t)t * D + c) * rs[t - lo];
            const f32x2 p = (sum * inv - xc) * Gv;
            *(unsigned*)(Pq + (size_t)t * D + c) = cvt_pk_bf16(p[0], p[1]);
        }
        __syncthreads();
    }
}

__device__ __forceinline__ void conv_phase(const bf16_t* GB, const bf16_t* U, const float* cw, bf16_t* Z) {
    const int tid = opaque_tid();
    const long total = (long)MTOT * 128, nth = (long)gridDim.x * NTHREADS;
    for (long idx = (long)blockIdx.x * NTHREADS + tid; idx < total; idx += nth) {
        const int m = (int)(idx >> 7), c8 = (int)(idx & 127) * 8;
        const int pos = m < MLAT ? (m & 4095) : ((m - MLAT) & 255), len = m < MLAT ? 4096 : 256;
        const u32x4 zero = (u32x4){0u, 0u, 0u, 0u};
        const u32x4 g4 = *(const u32x4*)(GB + (size_t)m * D + c8), u0 = *(const u32x4*)(U + (size_t)m * D + c8);
        const u32x4 um = pos > 0 ? *(const u32x4*)(U + (size_t)(m - 1) * D + c8) : zero;
        const u32x4 up = pos < len - 1 ? *(const u32x4*)(U + (size_t)(m + 1) * D + c8) : zero;
        float o[8];
#pragma unroll
        for (int e = 0; e < 4; ++e) {
            const int c = c8 + 2 * e;
            const f32x2 w0 = *(const f32x2*)(cw + c), w1 = *(const f32x2*)(cw + D + c), w2 = *(const f32x2*)(cw + 2 * D + c);
            o[2 * e] = bf_lo(g4[e]) * (bf_lo(um[e]) * w0[0] + bf_lo(u0[e]) * w1[0] + bf_lo(up[e]) * w2[0]);
            o[2 * e + 1] = bf_hi(g4[e]) * (bf_hi(um[e]) * w0[1] + bf_hi(u0[e]) * w1[1] + bf_hi(up[e]) * w2[1]);
        }
        u32x4 w; w.x = cvt_pk_bf16(o[0], o[1]); w.y = cvt_pk_bf16(o[2], o[3]); w.z = cvt_pk_bf16(o[4], o[5]); w.w = cvt_pk_bf16(o[6], o[7]);
        *(u32x4*)(Z + (size_t)m * D + c8) = w;
    }
}

__device__ __forceinline__ void attn_naive_phase(const bf16_t* Q, const bf16_t* Kb, const bf16_t* VT, bf16_t* O, const float* rpb, LAS float* pl_all, int nrows) {
    const int tid = opaque_tid(), lane = tid & 63, wave = __builtin_amdgcn_readfirstlane(tid >> 6);
    const int gw = blockIdx.x * NWAVES + wave, NGW = gridDim.x * NWAVES;
    LAS float* pl = pl_all + wave * 384;
    for (long task = gw; task < (long)nrows * NH; task += NGW) {
        const int m = (int)(task >> 4), h = (int)(task & 15);
        const bool lat = m < MLAT; const int b = lat ? (m >> 12) : ((m - MLAT) >> 8);
        int r = 0, qc = 0, start = 0, cs = 0;
        if (lat) { const int t = m & 4095; r = t >> 6; qc = t & 63; start = min(max(r - 4, 0), 56); cs = min(max(qc - 8, 0), 48); }
        const int ctxbase = MLAT + b * 256;
        u32x4 qv[8];
#pragma unroll
        for (int i = 0; i < 8; ++i) qv[i] = *(const u32x4*)(Q + (size_t)m * D + h * 64 + 8 * i);
        float s[6];
#pragma unroll
        for (int i = 0; i < 6; ++i) {
            int tok = 0; float bias = 0.f; bool valid = true;
            if (i < 2) {
                if (!lat) valid = false;
                else { const int j = lane + 64 * i, kr = start + (j >> 4), kc = cs + (j & 15); tok = b * 4096 + kr * 64 + kc;
                    bias = rpb[(h * 15 + (kr - r + 7)) * 31 + (kc - qc + 15)] * LOG2E; }
            } else tok = ctxbase + lane + 64 * (i - 2);
            float dot = 0.f;
            if (valid) {
                const bf16_t* kp = Kb + (size_t)tok * D + h * 64;
#pragma unroll
                for (int ii = 0; ii < 8; ++ii) { const u32x4 kv = *(const u32x4*)(kp + 8 * ii);
#pragma unroll
                    for (int e = 0; e < 4; ++e) dot += bf_lo(qv[ii][e]) * bf_lo(kv[e]) + bf_hi(qv[ii][e]) * bf_hi(kv[e]); }
                s[i] = dot + bias;
            } else s[i] = -INFINITY;
        }
        float mx = s[0];
#pragma unroll
        for (int i = 1; i < 6; ++i) mx = fmaxf(mx, s[i]);
        mx = wave_max(mx);
        float sum = 0.f;
#pragma unroll
        for (int i = 0; i < 6; ++i) { const float p = exp2f(s[i] - mx); sum += p; pl[lane + 64 * i] = p; }
        sum = wave_sum(sum);
        __builtin_amdgcn_wave_barrier();
        asm volatile("s_waitcnt lgkmcnt(0)" ::: "memory");
        const bf16_t* vrow = VT + (size_t)(h * 64 + lane) * MTOT;
        float o = 0.f;
        if (lat) {
            for (int j = 0; j < 128; ++j) { const int tok = b * 4096 + (start + (j >> 4)) * 64 + cs + (j & 15); o += pl[j] * bf2f(vrow[tok]); }
        }
        for (int l8 = 0; l8 < 32; ++l8) {
            const u32x4 vv = *(const u32x4*)(vrow + ctxbase + 8 * l8);
#pragma unroll
            for (int e = 0; e < 4; ++e) o += pl[128 + 8 * l8 + 2 * e] * bf_lo(vv[e]) + pl[128 + 8 * l8 + 2 * e + 1] * bf_hi(vv[e]);
        }
        const float res = o / sum;
        O[(size_t)m * D + h * 64 + lane] = (bf16_t)(cvt_pk_bf16(res, 0.f) & 0xffffu);
        __builtin_amdgcn_wave_barrier();
        asm volatile("s_waitcnt lgkmcnt(0)" ::: "memory");
    }
}


typedef float f32x16 __attribute__((ext_vector_type(16)));
constexpr int RPB_PAD = 64, RPB_N = NH * 15 * 31;
template <bool BAND>
__device__ __forceinline__ void attn_tile(const bf16_t* Kt, const bf16_t* Vt, const bf16x8 (&qr)[4], float& mref, float& l, f32x16& o0, f32x16& o1,
                                          const LAS float* brow, int lo, int r32, int hi) {
    bf16x8 kf[2][4];
#pragma unroll
    for (int p = 0; p < 2; ++p)
#pragma unroll
        for (int d0 = 0; d0 < 4; ++d0) kf[p][d0] = *(const bf16x8*)(Kt + (size_t)(r32 + 32 * p) * D + 16 * d0 + 8 * hi);
    u32x2 va[2][4], vb[2][4];
#pragma unroll
    for (int dh = 0; dh < 2; ++dh)
#pragma unroll
        for (int sl = 0; sl < 4; ++sl) { const bf16_t* vp = Vt + (size_t)(r32 + 32 * dh) * MTOT + 16 * sl + 4 * hi; va[dh][sl] = *(const u32x2*)vp; vb[dh][sl] = *(const u32x2*)(vp + 8); }
    f32x16 p0, p1;
#pragma unroll
    for (int r = 0; r < 16; ++r) { p0[r] = 0.f; p1[r] = 0.f; }
#pragma unroll
    for (int d0 = 0; d0 < 4; ++d0) { p0 = __builtin_amdgcn_mfma_f32_32x32x16_bf16(kf[0][d0], qr[d0], p0, 0, 0, 0); p1 = __builtin_amdgcn_mfma_f32_32x32x16_bf16(kf[1][d0], qr[d0], p1, 0, 0, 0); }
    if (BAND) {
#pragma unroll
        for (int r = 0; r < 16; ++r) { const int C0 = (r & 3) + 8 * (r >> 2);
            p0[r] = ((unsigned)(C0 - lo) < 16u) ? p0[r] + brow[C0] : -INFINITY;
            p1[r] = ((unsigned)(C0 + 32 - lo) < 16u) ? p1[r] + brow[C0 + 32] : -INFINITY; }
    }
    float mt = fmaxf(p0[0], p1[0]);
#pragma unroll
    for (int r = 1; r < 16; ++r) mt = fmaxf(mt, fmaxf(p0[r], p1[r]));
    mt = fmaxf(mt, __shfl_xor(mt, 32));
    if (__any(mt > mref + 8.0f)) {
        const float mnew = (mt > mref + 8.0f) ? mt : mref;
        const float alpha = __builtin_amdgcn_exp2f(mref - mnew);
        l *= alpha;
#pragma unroll
        for (int r = 0; r < 16; ++r) { o0[r] *= alpha; o1[r] *= alpha; }
        mref = mnew;
    }
    float ls = 0.f;
#pragma unroll
    for (int r = 0; r < 16; ++r) { p0[r] = __builtin_amdgcn_exp2f(p0[r] - mref); p1[r] = __builtin_amdgcn_exp2f(p1[r] - mref); ls += p0[r] + p1[r]; }
    l += ls;
    bf16x8 pf[4];
#pragma unroll
    for (int sl = 0; sl < 4; ++sl) {
        u32x4 w;
        if (sl < 2) { const int o = 8 * sl; w.x = cvt_pk_bf16(p0[o], p0[o + 1]); w.y = cvt_pk_bf16(p0[o + 2], p0[o + 3]); w.z = cvt_pk_bf16(p0[o + 4], p0[o + 5]); w.w = cvt_pk_bf16(p0[o + 6], p0[o + 7]); }
        else { const int o = 8 * (sl - 2); w.x = cvt_pk_bf16(p1[o], p1[o + 1]); w.y = cvt_pk_bf16(p1[o + 2], p1[o + 3]); w.z = cvt_pk_bf16(p1[o + 4], p1[o + 5]); w.w = cvt_pk_bf16(p1[o + 6], p1[o + 7]); }
        pf[sl] = __builtin_bit_cast(bf16x8, w);
    }
#pragma unroll
    for (int sl = 0; sl < 4; ++sl) {
        const u32x4 a0 = (u32x4){va[0][sl].x, va[0][sl].y, vb[0][sl].x, vb[0][sl].y}, a1 = (u32x4){va[1][sl].x, va[1][sl].y, vb[1][sl].x, vb[1][sl].y};
        o0 = __builtin_amdgcn_mfma_f32_32x32x16_bf16(__builtin_bit_cast(bf16x8, a0), pf[sl], o0, 0, 0, 0);
        o1 = __builtin_amdgcn_mfma_f32_32x32x16_bf16(__builtin_bit_cast(bf16x8, a1), pf[sl], o1, 0, 0, 0);
    }
}
__device__ __forceinline__ void attn_unit(const bf16_t* Q, const bf16_t* Kb, const bf16_t* VT, bf16_t* O, const LAS float* tab, int b, int h, int m0, bool lat, int r, int qc0, int lane) {
    const int r32 = lane & 31, hi = lane >> 5;
    bf16x8 qr[4];
#pragma unroll
    for (int d0 = 0; d0 < 4; ++d0) qr[d0] = *(const bf16x8*)(Q + (size_t)(m0 + r32) * D + h * 64 + 16 * d0 + 8 * hi);
    float mref = -INFINITY, l = 0.f; f32x16 o0, o1;
#pragma unroll
    for (int i = 0; i < 16; ++i) { o0[i] = 0.f; o1[i] = 0.f; }
    const bf16_t* Vh = VT + (size_t)(h * 64) * MTOT;
    const int ctxbase = MLAT + b * 256;
    for (int ti = 0; ti < 4; ++ti) {
        const int tok0 = ctxbase + 64 * ti;
        attn_tile<false>(Kb + (size_t)tok0 * D + h * 64, Vh + tok0, qr, mref, l, o0, o1, tab, 0, r32, hi);
    }
    if (lat) {
        const int qc = qc0 + r32, cs = min(max(qc - 8, 0), 48), start = min(max(r - 4, 0), 56);
        const int lo = cs - 4 * hi;
        const LAS float* lb = tab + RPB_PAD + h * 15 * 31 + (4 * hi - qc + 15);
        for (int ti = 0; ti < 8; ++ti) {
            const int kr = start + ti, tok0 = b * 4096 + kr * 64;
            attn_tile<true>(Kb + (size_t)tok0 * D + h * 64, Vh + tok0, qr, mref, l, o0, o1, lb + (kr - r + 7) * 31, lo, r32, hi);
        }
    }
    l += __shfl_xor(l, 32);
    const float inv = 1.0f / l;
    bf16_t* op = O + (size_t)(m0 + r32) * D + h * 64 + 4 * hi;
#pragma unroll
    for (int g = 0; g < 4; ++g) {
        u32x2 w0, w1;
        w0.x = cvt_pk_bf16(o0[4 * g] * inv, o0[4 * g + 1] * inv); w0.y = cvt_pk_bf16(o0[4 * g + 2] * inv, o0[4 * g + 3] * inv);
        w1.x = cvt_pk_bf16(o1[4 * g] * inv, o1[4 * g + 1] * inv); w1.y = cvt_pk_bf16(o1[4 * g + 2] * inv, o1[4 * g + 3] * inv);
        *(u32x2*)(op + 8 * g) = w0; *(u32x2*)(op + 32 + 8 * g) = w1;
    }
}
__device__ __forceinline__ void attn_phase(const bf16_t* Q, const bf16_t* Kb, const bf16_t* VT, bf16_t* O, const float* rpb, LAS float* tab, int nrows) {
    const int tid = opaque_tid(), lane = tid & 63, wave = __builtin_amdgcn_readfirstlane(tid >> 6);
    for (int i = tid; i < RPB_N + 2 * RPB_PAD; i += NTHREADS) { const int k = i - RPB_PAD; tab[i] = (k >= 0 && k < RPB_N) ? rpb[k] * LOG2E : 0.f; }
    __syncthreads();
    for (int wi = blockIdx.x; wi < 256; wi += gridDim.x) {
        const int bh = wi >> 2, rg = wi & 3, b = bh >> 4, h = bh & 15;
        for (int u = 0; u < 4; ++u) {
            const int r = rg * 16 + 2 * wave + (u >> 1), half = u & 1;
            attn_unit(Q, Kb, VT, O, tab, b, h, b * 4096 + r * 64 + 32 * half, true, r, 32 * half, lane);
        }
    }
    if (nrows == MTOT) {
        const int gw = blockIdx.x * NWAVES + wave, NGW = gridDim.x * NWAVES;
        for (int cu = gw; cu < 2048; cu += NGW) {
            if ((cu & 3) == 0) { const int un = cu >> 2, b = un >> 7, h = (un >> 3) & 15, blk = un & 7;
                attn_unit(Q, Kb, VT, O, tab, b, h, MLAT + b * 256 + blk * 32, false, 0, 0, lane); }
        }
    }
    __syncthreads();
}

__global__ void __launch_bounds__(NTHREADS, 2) mk_fwd(Args P) {
    extern __shared__ __attribute__((aligned(16))) unsigned char lds_raw[];
    LAS unsigned char* lds = (LAS unsigned char*)lds_raw;
    cg::grid_group grid = cg::this_grid();
    const int G = gridDim.x, bx = blockIdx.x;
    unsigned char* ws = P.ws;
    float* mods = (float*)(ws + WS_MODS);
    float* X = (float*)(ws + WS_X);
    bf16_t* H = (bf16_t*)(ws + WS_H);
    bf16_t* Qb = (bf16_t*)(ws + WS_Q); bf16_t* Kb = (bf16_t*)(ws + WS_K); bf16_t* VT = (bf16_t*)(ws + WS_VT); bf16_t* Ob = (bf16_t*)(ws + WS_O);
    bf16_t* Gb = (bf16_t*)(ws + WS_G);
    constexpr size_t TS1024 = (size_t)256 * 1024 * 2;

    prologue_phase(P, lds);
    grid.sync();

    for (int layer = 0; layer < NLAYER; ++layer) {
        const int kind = layer % 3, j = layer / 3;
        const bool lastl = (layer == NLAYER - 1);
        const int nrows = lastl ? MLAT : MTOT;
        const float* mods_l = mods + (size_t)layer * 5 * NMOD;
        const float* xin_lat = layer == 0 ? P.x : X;
        const float* xin_ctx = layer == 0 ? P.ctx : X + (size_t)MLAT * D;

        if (kind == 0) {
            norm_phase(xin_lat, xin_ctx, P.norm_mix_g + layer * D, mods_l, 0, 1, H, MTOT);
            grid.sync();
            {
                const bf16_t* Wt = (const bf16_t*)(ws + WS_WQKV) + (size_t)j * 3 * D * D;
                pg8::Sched S; S.init1(H, TS1024, Wt, TS1024, MTOT / 256, 8, G, bx);
                S.add2(Wt + (size_t)2 * D * D, TS1024, H, TS1024, 4, MTOT / 256);
                pg8::EpiQKV E{Qb, Kb, VT};
                pg8::gemm_phase<pg8::EpiQKV>(lds, D, D, D, S, E);
            }
            grid.sync();
            attn_phase(Qb, Kb, VT, Ob, P.na_rpb + (size_t)j * NH * 15 * 31, (LAS float*)lds, nrows);
            grid.sync();
            {
                const bf16_t* Wt = (const bf16_t*)(ws + WS_WO) + (size_t)j * D * D;
                pg8::Sched S; S.init1(Ob, TS1024, Wt, TS1024, nrows / 256, 4, G, bx);
                pg8::EpiRes E{xin_lat, xin_ctx, X, mods_l + 2 * D, nullptr};
                pg8::gemm_phase<pg8::EpiRes>(lds, D, D, D, S, E);
            }
            grid.sync();
        } else if (kind == 1) {
            norm_phase(xin_lat, xin_ctx, P.norm_mix_g + layer * D, mods_l, 0, 1, H, MTOT);
            grid.sync();
            {
                const bf16_t* Wt = (const bf16_t*)(ws + WS_WSCIN);
                pg8::Sched S; S.init1(H, TS1024, Wt, TS1024, MTOT / 256, 12, G, bx);
                pg8::EpiSCin E{Qb, Kb};
                pg8::gemm_phase<pg8::EpiSCin>(lds, D, D, D, S, E);
            }
            grid.sync();
            conv_phase(Qb, Kb, P.sc_conv_w + (size_t)j * 3 * D, Ob);
            grid.sync();
            {
                const bf16_t* Wt = (const bf16_t*)(ws + WS_WSCOUT);
                pg8::Sched S; S.init1(Ob, TS1024, Wt, TS1024, nrows / 256, 4, G, bx);
                pg8::EpiRes E{xin_lat, xin_ctx, X, mods_l + 2 * D, nullptr};
                pg8::gemm_phase<pg8::EpiRes>(lds, D, D, D, S, E);
            }
            grid.sync();
        } else {
            pool_phase(X, P.norm_mix_g + layer * D, mods_l, H, (LAS float*)lds);
            grid.sync();
            {
                const bf16_t* Wt = (const bf16_t*)(ws + WS_WPOOL);
                pg8::Sched S; S.init1(H, TS1024, Wt, (size_t)256 * 256 * 2, nrows / 256, 4, G, bx); S.apn = 512;
                pg8::EpiRes E{xin_lat, xin_ctx, X, mods_l + 2 * D, P.pool_scale + (size_t)j * D};
                pg8::gemm_phase<pg8::EpiRes>(lds, 256, D, 256, S, E);
            }
            grid.sync();
        }
        norm_phase(X, X + (size_t)MLAT * D, P.norm_ffn_g + layer * D, mods_l, 3, 4, H, nrows);
        grid.sync();
        {
            const bf16_t* Wt = (const bf16_t*)(ws + WS_W13) + (size_t)layer * 2 * FF * D;
            pg8::Sched S; S.init1(H, TS1024, Wt, TS1024, nrows / 256, 2 * FF / 256, G, bx);
            pg8::EpiSwi E{Gb};
            pg8::gemm_phase<pg8::EpiSwi>(lds, D, D, D, S, E);
        }
        grid.sync();
        {
            const bf16_t* Wt = (const bf16_t*)(ws + WS_W2) + (size_t)layer * D * FF;
            pg8::Sched S; S.init1(Gb, (size_t)256 * FF * 2, Wt, (size_t)256 * FF * 2, nrows / 256, 4, G, bx);
            pg8::EpiRes E{X, X + (size_t)MLAT * D, X, mods_l + 5 * D, nullptr};
            pg8::gemm_phase<pg8::EpiRes>(lds, FF, FF, FF, S, E);
        }
        grid.sync();
    }
    final_norm_phase(X, P.final_g, P.out);
}

extern "C" void kernel_launch(void* const* d_in, const int* in_sizes, int n_in, void* d_out, int out_size, void* d_ws, size_t ws_size, hipStream_t stream) {
    static int grid = 0;
    if (grid == 0) {
        if (n_in != 20 || ws_size < WS_END) { fprintf(stderr, "kernel_launch: unexpected n_in %d / ws_size %zu\n", n_in, ws_size); grid = -1; return; }
        int dev = 0, cus = 0, per_cu = 0;
        hipGetDevice(&dev);
        hipDeviceGetAttribute(&cus, hipDeviceAttributeMultiprocessorCount, dev);
        if (hipFuncSetAttribute((const void*)mk_fwd, hipFuncAttributeMaxDynamicSharedMemorySize, LDS_BYTES) != hipSuccess) { fprintf(stderr, "kernel_launch: hipFuncSetAttribute failed\n"); }
        if (hipOccupancyMaxActiveBlocksPerMultiprocessor(&per_cu, (const void*)mk_fwd, NTHREADS, LDS_BYTES) != hipSuccess || per_cu < 1) { fprintf(stderr, "kernel_launch: occupancy query says %d\n", per_cu); per_cu = 1; }
        (void)hipGetLastError();
        grid = cus * 1;
        if (grid <= 0) grid = 256;
    }
    if (grid < 0) return;
    Args a{};
    const float** f = (const float**)&a;
    for (int i = 0; i < 20; ++i) f[i] = (const float*)d_in[i];
    a.out = (float*)d_out; a.ws = (unsigned char*)d_ws;
    void* args[] = {&a};
    hipError_t e = hipLaunchCooperativeKernel((const void*)mk_fwd, dim3(grid), dim3(NTHREADS), args, LDS_BYTES, stream);
    if (e != hipSuccess) fprintf(stderr, "cooperative launch failed: %s (grid %d)\n", hipGetErrorString(e), grid);
}
```

```cpp
#include <hip/hip_runtime.h>
#include <hip/hip_cooperative_groups.h>
#include <cstdio>
#include <cstdint>
namespace cg = cooperative_groups;

#define LAS __attribute__((address_space(3)))
typedef unsigned short bf16_t;
typedef short bf16x8 __attribute__((ext_vector_type(8)));
typedef float f32x4 __attribute__((ext_vector_type(4)));
typedef float f32x2 __attribute__((ext_vector_type(2)));
typedef unsigned u32x4 __attribute__((ext_vector_type(4)));
typedef unsigned u32x2 __attribute__((ext_vector_type(2)));

constexpr int D = 1024, NB = 4, SEQ = 4096, CTXL = 256, NLAYER = 4, FF = 2816, NH = 16, HD = 64;
constexpr int MLAT = NB * SEQ, MCTX = NB * CTXL, MTOT = MLAT + MCTX;
constexpr int NMOD = 6 * D;
constexpr float EPS = 1e-6f;
constexpr float LOG2E = 1.4426950408889634f;
constexpr float QSCALE = 0.125f * LOG2E;

constexpr size_t MiB = 1u << 20;
constexpr size_t WS_MODS = 0;
constexpr size_t WS_WQKV = 1 * MiB;
constexpr size_t WS_WO = 13 * MiB;
constexpr size_t WS_WSCIN = 17 * MiB;
constexpr size_t WS_WSCOUT = 23 * MiB;
constexpr size_t WS_WPOOL = 25 * MiB;
constexpr size_t WS_W13 = 26 * MiB;
constexpr size_t WS_W2 = 70 * MiB;
constexpr size_t WS_X = 92 * MiB;
constexpr size_t WS_H = 160 * MiB;
constexpr size_t WS_Q = 194 * MiB;
constexpr size_t WS_K = 228 * MiB;
constexpr size_t WS_VT = 262 * MiB;
constexpr size_t WS_O = 296 * MiB;
constexpr size_t WS_G = 194 * MiB;
constexpr size_t WS_CTL = 330 * MiB;
constexpr size_t CTL_ZERO_BYTES = 65536;
constexpr size_t WS_END = 331 * MiB;
static_assert(WS_G + (size_t)MTOT * FF * 2 <= WS_O, "G overlay");

#ifndef EXP_SYNC
#define EXP_SYNC 0
#endif
#ifndef EXP_ATTN
#define EXP_ATTN 0
#endif
#ifndef EXP_PRO
#define EXP_PRO 0
#endif
#ifndef EXP_NORM
#define EXP_NORM 0
#endif
#ifndef EXP_UP
#define EXP_UP 0
#endif
constexpr int LDS_BYTES = 147456;
constexpr int LDS_MISC_OFF = 131072 + 1024;
constexpr int NWAVES = 8, NTHREADS = 512;

__device__ __forceinline__ int opaque_tid() { int t = threadIdx.x; asm volatile("" : "+v"(t)); return t; }
__device__ __forceinline__ unsigned cvt_pk_bf16(float lo, float hi) { unsigned r; asm volatile("v_cvt_pk_bf16_f32 %0, %1, %2" : "=v"(r) : "v"(lo), "v"(hi)); return r; }
__device__ __forceinline__ float bf_lo(unsigned w) { return __uint_as_float(w << 16); }
__device__ __forceinline__ float bf_hi(unsigned w) { return __uint_as_float(w & 0xffff0000u); }
__device__ __forceinline__ float bf2f(bf16_t v) { return __uint_as_float(((unsigned)v) << 16); }
__device__ __forceinline__ float silu_f(float x) { return x * __builtin_amdgcn_rcpf(1.0f + __expf(-x)); }
__device__ __forceinline__ float wave_sum(float v) {
#pragma unroll
    for (int o = 1; o < 64; o <<= 1) v += __shfl_xor(v, o);
    return v;
}
__device__ __forceinline__ float wave_max(float v) {
#pragma unroll
    for (int o = 1; o < 64; o <<= 1) v = fmaxf(v, __shfl_xor(v, o));
    return v;
}

namespace pg8 {
constexpr int BM = 256, BK = 64, HALF = 128, HTB = HALF * BK * 2, STAGE_BYTES = 8 * HTB, NXCD = 8, WGM = 8;
__host__ __device__ __forceinline__ int lds_byte(int r, int c) { const int st = (r >> 4) * 2 + (c >> 5), rr = r & 15, cc = c & 31, ob = rr * 64 + cc * 2; return st * 1024 + (ob ^ (((ob >> 9) & 1) << 5)); }
__host__ __device__ __forceinline__ void stage_rc(int b, int& R, int& C) { const int st = b / 1024, sb = b % 1024, swz = sb ^ (((sb >> 9) & 1) << 5); R = (st >> 1) * 16 + swz / 64; C = (st & 1) * 32 + (swz % 64) / 2; }
__host__ __device__ __forceinline__ int perm32(int rho) { const int n = rho >> 4, i = rho & 15; return 8 * (i >> 2) + 4 * n + (i & 3); }

struct Unit { const char* a; const char* b; int pm, pn, fam; };

struct Sched {
    const char* A1; const char* B1; size_t tsA1, tsB1, apn; int nM1, nN1, nwg1;
    const char* A2; const char* B2; size_t tsA2, tsB2; int nM2, nN2;
    int nwg, G, c;
    __device__ void init1(const void* A, size_t tsA, const void* B, size_t tsB, int nM, int nN, int G_, int c_) {
        A1 = (const char*)A; B1 = (const char*)B; tsA1 = tsA; tsB1 = tsB; apn = 0; nM1 = nM; nN1 = nN; nwg1 = nM * nN;
        A2 = nullptr; B2 = nullptr; tsA2 = 0; tsB2 = 0; nM2 = 0; nN2 = 0; nwg = nwg1; G = G_; c = c_;
    }
    __device__ void add2(const void* A, size_t tsA, const void* B, size_t tsB, int nM, int nN) {
        A2 = (const char*)A; B2 = (const char*)B; tsA2 = tsA; tsB2 = tsB; nM2 = nM; nN2 = nN; nwg = nwg1 + nM * nN;
    }
    __device__ bool next(int i, Unit& u) const {
        const long L = (long)i * G + c; if (L >= nwg) return false;
        int wgid = (int)L; { const int q = nwg / NXCD, r = nwg % NXCD, xcd = wgid % NXCD, off = wgid / NXCD; wgid = (xcd < r ? xcd * (q + 1) : r * (q + 1) + (xcd - r) * q) + off; }
        if (wgid < nwg1) {
            const int nig = WGM * nN1, gid = wgid / nig, fm = gid * WGM, gsz = (nM1 - fm) < WGM ? (nM1 - fm) : WGM;
            u.pm = fm + ((wgid % nig) % gsz); u.pn = (wgid % nig) / gsz; u.fam = 0;
            u.a = A1 + (size_t)u.pm * tsA1 + (size_t)u.pn * apn; u.b = B1 + (size_t)u.pn * tsB1;
        } else {
            const int w2 = wgid - nwg1; u.pm = w2 % nM2; u.pn = w2 / nM2; u.fam = 1;
            u.a = A2 + (size_t)u.pm * tsA2; u.b = B2 + (size_t)u.pn * tsB2;
        }
        return true;
    }
};

typedef f32x4 Acc[2][2][4][2];

__device__ __forceinline__ void store_plain(const Acc& acc, bf16_t* base, size_t ldc, int row0, int col0, float sc, int wr, int wc, int fr, int fq) {
#pragma unroll
    for (int ai = 0; ai < 2; ++ai)
#pragma unroll
        for (int m = 0; m < 4; ++m) {
            bf16_t* rowp = base + (size_t)(row0 + wr * 64 + fr + ai * HALF + m * 16) * ldc + col0 + wc * 32 + 8 * fq;
#pragma unroll
            for (int bj = 0; bj < 2; ++bj) {
                const f32x4 v0 = acc[ai][bj][m][0] * sc, v1 = acc[ai][bj][m][1] * sc;
                u32x4 w; w.x = cvt_pk_bf16(v0[0], v0[1]); w.y = cvt_pk_bf16(v0[2], v0[3]); w.z = cvt_pk_bf16(v1[0], v1[1]); w.w = cvt_pk_bf16(v1[2], v1[3]);
                *(u32x4*)(rowp + bj * HALF) = w;
            }
        }
}
template <int ACT>
__device__ __forceinline__ void store_pair(const Acc& acc, bf16_t* base, size_t ldc, int row0, int col0, int wr, int wc, int fr, int fq) {
#pragma unroll
    for (int ai = 0; ai < 2; ++ai)
#pragma unroll
        for (int m = 0; m < 4; ++m) {
            bf16_t* rowp = base + (size_t)(row0 + wr * 64 + fr + ai * HALF + m * 16) * ldc + col0 + wc * 32 + 8 * fq;
            float o[8];
#pragma unroll
            for (int n = 0; n < 2; ++n)
#pragma unroll
                for (int e = 0; e < 4; ++e) { const float a = acc[ai][0][m][n][e], b = acc[ai][1][m][n][e]; o[n * 4 + e] = (ACT == 1 ? silu_f(a) : a) * b; }
            u32x4 w; w.x = cvt_pk_bf16(o[0], o[1]); w.y = cvt_pk_bf16(o[2], o[3]); w.z = cvt_pk_bf16(o[4], o[5]); w.w = cvt_pk_bf16(o[6], o[7]);
            *(u32x4*)rowp = w;
        }
}

struct EpiQKV {
    static constexpr bool PERM = true;
    bf16_t *Q, *K, *VT;
    __device__ __forceinline__ void operator()(const Acc& acc, const Unit& u, int wr, int wc, int fr, int fq) const {
        if (u.fam == 0) {
            if (u.pn < 4) store_plain(acc, Q, D, u.pm * BM, u.pn * BM, QSCALE, wr, wc, fr, fq);
            else store_plain(acc, K, D, u.pm * BM, (u.pn - 4) * BM, 1.0f, wr, wc, fr, fq);
        } else store_plain(acc, VT, MTOT, u.pm * BM, u.pn * BM, 1.0f, wr, wc, fr, fq);
    }
};
struct EpiSCin {
    static constexpr bool PERM = true;
    bf16_t *GB, *U;
    __device__ __forceinline__ void operator()(const Acc& acc, const Unit& u, int wr, int wc, int fr, int fq) const {
        if (u.pn < 4) store_plain(acc, GB, D, u.pm * BM, u.pn * BM, 1.0f, wr, wc, fr, fq);
        else store_pair<0>(acc, U, D, u.pm * BM, (u.pn - 4) * HALF, wr, wc, fr, fq);
    }
};
struct EpiSwi {
    static constexpr bool PERM = true;
    bf16_t* Gb;
    __device__ __forceinline__ void operator()(const Acc& acc, const Unit& u, int wr, int wc, int fr, int fq) const {
        store_pair<1>(acc, Gb, FF, u.pm * BM, u.pn * HALF, wr, wc, fr, fq);
    }
};
struct EpiRes {
    static constexpr bool PERM = false;
    const float* res_lat; const float* res_ctx; float* X; const float* gate;   const float* cscale;
    __device__ __forceinline__ void operator()(const Acc& acc, const Unit& u, int wr, int wc, int fr, int fq) const {
        const int row0 = u.pm * BM, colb = u.pn * BM + wc * 32 + 4 * fq;
        const bool lat = row0 < MLAT; const int mb = lat ? (row0 >> 12) : 4;
        const float* gp = gate + (size_t)mb * NMOD;
        const float* rbase = lat ? res_lat : res_ctx - (size_t)MLAT * D;
        f32x4 gv[2][2];
#pragma unroll
        for (int bj = 0; bj < 2; ++bj)
#pragma unroll
            for (int n = 0; n < 2; ++n) { const int c = colb + bj * HALF + n * 16; f32x4 g = *(const f32x4*)(gp + c); if (cscale) g = g * *(const f32x4*)(cscale + c); gv[bj][n] = g; }
#pragma unroll
        for (int ai = 0; ai < 2; ++ai)
#pragma unroll
            for (int m = 0; m < 4; ++m) {
                const size_t off = (size_t)(row0 + wr * 64 + fr + ai * HALF + m * 16) * D;
#pragma unroll
                for (int bj = 0; bj < 2; ++bj)
#pragma unroll
                    for (int n = 0; n < 2; ++n) { const int c = colb + bj * HALF + n * 16; const f32x4 r = *(const f32x4*)(rbase + off + c); *(f32x4*)(X + off + c) = r + gv[bj][n] * acc[ai][bj][m][n]; }
                asm volatile("" ::: "memory");
            }
    }
};

template <class Epi>
__device__ __forceinline__ void gemm_phase(LAS unsigned char* lds, const int K, const int lda, const int ldb, const Sched& S, const Epi& E) {
    const int tid = opaque_tid(), wid = __builtin_amdgcn_readfirstlane(tid >> 6), lane = tid & 63, wr = wid >> 2, wc = wid & 3, fr = lane & 15, fq = lane >> 4;
    const int nt = K / BK;
    unsigned voffA[2], voffB[2];
#pragma unroll
    for (int i = 0; i < 2; ++i) { int R, C; stage_rc(tid * 16 + i * 8192, R, C); const int Rb = Epi::PERM ? ((R & ~31) + perm32(R & 31)) : R;
        voffA[i] = (unsigned)(R * lda + C) * 2u; voffB[i] = (unsigned)(Rb * ldb + C) * 2u; }
    const size_t kstep = (size_t)(BK * 2);
    const size_t hsA = (size_t)HALF * lda * 2, hsB = (size_t)HALF * ldb * 2;
    const unsigned ldsw = (unsigned)wid * 1024u;
    const int aoff = lds_byte(wr * 64 + fr, fq * 8), boff = lds_byte(wc * 32 + fr, fq * 8);
#define PG8_SA(b, h) (((b) * 2 + (h)) * HTB)
#define PG8_SB(b, h) ((4 + (b) * 2 + (h)) * HTB)
#define PG8_STAGE(bufoff, gbase, voff) do { _Pragma("unroll") for (int _i = 0; _i < 2; ++_i) \
        __builtin_amdgcn_global_load_lds((const unsigned*)((const char*)(gbase) + (voff)[_i]), (LAS unsigned*)(lds + (bufoff) + ldsw + _i * 8192), 16, 0, 0); } while (0)
#define PG8_LDA(dst, b, h) do { _Pragma("unroll") for (int m = 0; m < 4; ++m) _Pragma("unroll") for (int k = 0; k < 2; ++k) dst[m][k] = *(const LAS bf16x8*)(lds + PG8_SA(b, h) + aoff + m * 2048 + k * 1024); } while (0)
#define PG8_LDB(dst, b, h) do { _Pragma("unroll") for (int n = 0; n < 2; ++n) _Pragma("unroll") for (int k = 0; k < 2; ++k) dst[n][k] = *(const LAS bf16x8*)(lds + PG8_SB(b, h) + boff + n * 2048 + k * 1024); } while (0)
#define PG8_MMA(ai, bj, At, Bt) do { __builtin_amdgcn_s_setprio(1); _Pragma("unroll") for (int m = 0; m < 4; ++m) _Pragma("unroll") for (int n = 0; n < 2; ++n) _Pragma("unroll") for (int k = 0; k < 2; ++k) \
        acc[ai][bj][m][n] = __builtin_amdgcn_mfma_f32_16x16x32_bf16(Bt[n][k], At[m][k], acc[ai][bj][m][n], 0, 0, 0); __builtin_amdgcn_s_setprio(0); } while (0)
#define PG8_WAIT_V(n) asm volatile("s_waitcnt vmcnt(" #n ")" ::: "memory")
#define PG8_WAIT_L(n) asm volatile("s_waitcnt lgkmcnt(" #n ")" ::: "memory")
#define PG8_BAR __builtin_amdgcn_s_barrier()
#define PG8_SCHED __builtin_amdgcn_sched_barrier(0)
    Unit cur, nxt; int ui = 0;
    if (!S.next(0, cur)) return;
    Acc acc;
#pragma unroll
    for (int a = 0; a < 2; ++a)
#pragma unroll
        for (int b = 0; b < 2; ++b)
#pragma unroll
            for (int m = 0; m < 4; ++m)
#pragma unroll
                for (int n = 0; n < 2; ++n) acc[a][b][m][n] = (f32x4){0.f, 0.f, 0.f, 0.f};
    bf16x8 At[4][2], B0[2][2], B1[2][2];
    const char* cA = cur.a; const char* cB = cur.b;
    PG8_STAGE(PG8_SB(0, 0), cB, voffB); PG8_STAGE(PG8_SB(0, 1), cB + hsB, voffB); PG8_STAGE(PG8_SA(0, 0), cA, voffA); PG8_STAGE(PG8_SA(0, 1), cA + hsA, voffA);
    if (wr == 1) PG8_BAR;
    PG8_WAIT_V(2); PG8_BAR;
    PG8_STAGE(PG8_SB(1, 0), cB + kstep, voffB); PG8_STAGE(PG8_SA(1, 0), cA + kstep, voffA); PG8_STAGE(PG8_SB(1, 1), cB + hsB + kstep, voffB);
    PG8_WAIT_V(6); PG8_BAR;
    for (;;) {
        const bool has_next = S.next(ui + 1, nxt);
        const char* nA = has_next ? nxt.a : cA; const char* nB = has_next ? nxt.b : cB;
        for (int t = 0; t < nt; t += 2) {
            const bool last = (t == nt - 2);
            const char* a1 = cA + (size_t)(t + 1) * kstep;
            const char* a2 = last ? nA : cA + (size_t)(t + 2) * kstep; const char* b2 = last ? nB : cB + (size_t)(t + 2) * kstep;
            const char* a3 = a2 + kstep; const char* b3 = b2 + kstep;
            PG8_LDB(B0, 0, 0); PG8_LDB(B1, 0, 1); PG8_SCHED; PG8_LDA(At, 0, 0); PG8_STAGE(PG8_SA(1, 1), a1 + hsA, voffA);
            PG8_WAIT_V(8); PG8_WAIT_L(0); PG8_BAR; PG8_MMA(0, 0, At, B0); PG8_MMA(0, 1, At, B1); PG8_BAR; PG8_SCHED;
            PG8_LDA(At, 0, 1); PG8_STAGE(PG8_SB(0, 0), b2, voffB); PG8_STAGE(PG8_SB(0, 1), b2 + hsB, voffB); PG8_STAGE(PG8_SA(0, 0), a2, voffA);
            PG8_WAIT_V(8); PG8_WAIT_L(0); PG8_BAR; PG8_MMA(1, 0, At, B0); PG8_MMA(1, 1, At, B1); PG8_BAR; PG8_SCHED;
            PG8_LDB(B0, 1, 0); PG8_LDB(B1, 1, 1); PG8_SCHED; PG8_LDA(At, 1, 0); PG8_STAGE(PG8_SA(0, 1), a2 + hsA, voffA);
            PG8_WAIT_V(8); PG8_WAIT_L(0); PG8_BAR; PG8_MMA(0, 0, At, B0); PG8_MMA(0, 1, At, B1); PG8_BAR; PG8_SCHED;
            PG8_LDA(At, 1, 1); PG8_STAGE(PG8_SB(1, 0), b3, voffB); PG8_STAGE(PG8_SB(1, 1), b3 + hsB, voffB); PG8_STAGE(PG8_SA(1, 0), a3, voffA);
            PG8_WAIT_V(8); PG8_WAIT_L(0); PG8_BAR; PG8_MMA(1, 0, At, B0); PG8_MMA(1, 1, At, B1); PG8_BAR; PG8_SCHED;
        }
        if (wr == 0) PG8_BAR;
        E(acc, cur, wr, wc, fr, fq);
        if (!has_next) break;
#pragma unroll
        for (int a = 0; a < 2; ++a)
#pragma unroll
            for (int b = 0; b < 2; ++b)
#pragma unroll
                for (int m = 0; m < 4; ++m)
#pragma unroll
                    for (int n = 0; n < 2; ++n) acc[a][b][m][n] = (f32x4){0.f, 0.f, 0.f, 0.f};
        cur = nxt; cA = nA; cB = nB; ++ui;
        if (wr == 1) PG8_BAR;
    }
    PG8_WAIT_V(0);
    PG8_BAR;
#undef PG8_SA
#undef PG8_SB
#undef PG8_STAGE
#undef PG8_LDA
#undef PG8_LDB
#undef PG8_MMA
#undef PG8_WAIT_V
#undef PG8_WAIT_L
#undef PG8_BAR
#undef PG8_SCHED
}
}


#define XB_TMO      128
#define XB_XCNT(j)  (256  + 64 * (j))
#define XB_XSUB(j)  (1280 + 64 * (j))
#define XB_XGEN(j)  (2304 + 64 * (j))
#define XB_TOP      3328
#define XB_TOPGEN   3392
#define XCD_BAR_WORDS 3456
#define XB_SPIN_CAP (1u << 18)
__device__ __forceinline__ unsigned xb_ld(unsigned* p)              { return __hip_atomic_load(p, __ATOMIC_RELAXED, __HIP_MEMORY_SCOPE_AGENT); }
__device__ __forceinline__ unsigned xb_add(unsigned* p, unsigned v) { return __hip_atomic_fetch_add(p, v, __ATOMIC_RELAXED, __HIP_MEMORY_SCOPE_AGENT); }
__device__ __forceinline__ unsigned xb_xcc_id() { return (unsigned)__builtin_amdgcn_s_getreg((3 << 11) | 20) & 0xFu; }
#define XB_SPIN(cond, bar) do { unsigned _sp = 0; while (cond) { __builtin_amdgcn_s_sleep(1); \
    if ((++_sp & 255u) == 0u) { if (xb_ld(&(bar)[XB_TMO])) break; if (_sp > XB_SPIN_CAP) { atomicAdd(&(bar)[XB_TMO], 1u); break; } } } } while (0)
struct XcdBarrier { unsigned* bar; unsigned x; volatile LAS unsigned* st; };
__device__ __forceinline__ XcdBarrier xcd_barrier_post(unsigned* bar, volatile LAS unsigned* st) {
    XcdBarrier b; b.bar = bar; b.x = xb_xcc_id(); b.st = st;
    if (threadIdx.x == 0) (void)xb_add(&bar[XB_XCNT(b.x)], 1u);
    return b;
}
__device__ __forceinline__ void xcd_barrier_complete(unsigned* bar, unsigned x, unsigned& nloc, unsigned& nx) {
    const unsigned G = gridDim.x * gridDim.y * gridDim.z;
    unsigned sum, cnt, mine, sp = 0u;
    for (;;) {
        sum = 0u; cnt = 0u; mine = 0u;
#pragma unroll
        for (unsigned j = 0; j < 16; ++j) { const unsigned c = xb_ld(&bar[XB_XCNT(j)]); sum += c; cnt += (c > 0u) ? 1u : 0u; mine = (j == x) ? c : mine; }
        if (sum == G) break;
        __builtin_amdgcn_s_sleep(1);
        if ((++sp & 255u) == 0u) { if (xb_ld(&bar[XB_TMO])) break; if (sp > XB_SPIN_CAP) { atomicAdd(&bar[XB_TMO], 1u); break; } }
    }
    nloc = mine > 0u ? mine : 1u; nx = cnt > 0u ? cnt : 1u;
}
__device__ __forceinline__ void xcd_barrier(const XcdBarrier& b) {
    asm volatile("s_waitcnt vmcnt(0)" ::: "memory");
    __syncthreads();
    if (threadIdx.x == 0) {
        unsigned* bar = b.bar;
        __builtin_amdgcn_s_waitcnt(0);
        unsigned nloc = b.st[0], nx = b.st[1];
        if (nloc == 0u) { xcd_barrier_complete(bar, b.x, nloc, nx); b.st[0] = nloc; b.st[1] = nx; }
        const unsigned old = xb_add(&bar[XB_XSUB(b.x)], 1u);
        const unsigned gen = old / nloc;
        if (old + 1u == (gen + 1u) * nloc) {
            __builtin_amdgcn_fence(__ATOMIC_RELEASE, "agent");
            asm volatile("s_waitcnt vmcnt(0)" ::: "memory");
            const unsigned og = xb_add(&bar[XB_TOP], 1u);
            const unsigned tg = og / nx;
            if (og + 1u == (tg + 1u) * nx) xb_add(&bar[XB_TOPGEN], 1u);
            else XB_SPIN(xb_ld(&bar[XB_TOPGEN]) == tg, bar);
            __builtin_amdgcn_fence(__ATOMIC_ACQUIRE, "agent");
            xb_add(&bar[XB_XGEN(b.x)], 1u);
            asm volatile("s_waitcnt vmcnt(0)" ::: "memory");
        } else {
            XB_SPIN(xb_ld(&bar[XB_XGEN(b.x)]) == gen, bar);
            __builtin_amdgcn_fence(__ATOMIC_ACQUIRE, "agent");
            asm volatile("s_waitcnt vmcnt(0)" ::: "memory");
        }
    }
    __syncthreads();
}

struct Args {
    const float *x, *c, *ctx, *c_ctx, *adaln_w, *adaln_b, *norm_mix_g, *norm_ffn_g, *ffn_w1, *ffn_w3, *ffn_w2;
    const float *na_w_qkv, *na_w_o, *na_rpb, *sc_w_in, *sc_conv_w, *sc_w_out, *pool_w, *pool_scale, *final_g;
    float* out; unsigned char* ws;
};

__device__ __forceinline__ void transpose_item(const float* W, int N, int k0, int n0, bf16_t* WT, int ldk, int row_base, LAS float* scr, int lane) {
#pragma unroll 8
    for (int i = 0; i < 32; ++i) { const int kk = 2 * i + (lane >> 5); scr[kk * 33 + (lane & 31)] = W[(size_t)(k0 + kk) * N + n0 + (lane & 31)]; }
    asm volatile("s_waitcnt lgkmcnt(0)" ::: "memory");
    const int c = lane & 7;
#pragma unroll
    for (int j = 0; j < 4; ++j) { const int n = (lane >> 3) + 8 * j; const LAS float* s = scr + (8 * c) * 33 + n;
        u32x4 o; o.x = cvt_pk_bf16(s[0 * 33], s[1 * 33]); o.y = cvt_pk_bf16(s[2 * 33], s[3 * 33]); o.z = cvt_pk_bf16(s[4 * 33], s[5 * 33]); o.w = cvt_pk_bf16(s[6 * 33], s[7 * 33]);
        *(u32x4*)(WT + (size_t)(row_base + n) * ldk + k0 + 8 * c) = o; }
    asm volatile("s_waitcnt lgkmcnt(0)" ::: "memory");
}

__device__ __forceinline__ void prologue_phase(const Args& P, LAS unsigned char* lds) {
    const int tid = opaque_tid(), lane = tid & 63, wave = __builtin_amdgcn_readfirstlane(tid >> 6);
    unsigned char* ws = P.ws;
    LAS float* S = (LAS float*)lds;
    LAS float* red = (LAS float*)(lds + 5 * 1024 * 4);
    for (int i = tid; i < 5 * D; i += NTHREADS) { const float v = i < 4 * D ? P.c[i] : P.c_ctx[i - 4 * D]; S[i] = v / (1.0f + __expf(-v)); }
    __syncthreads();
    float* mods = (float*)(ws + WS_MODS);
    for (int item = blockIdx.x; item < NLAYER * (NMOD / 32); item += gridDim.x) {
        const int layer = item / (NMOD / 32), c0 = (item % (NMOD / 32)) * 32;
        const int kk = lane >> 3, cgp = lane & 7;
        const float* W = P.adaln_w + (size_t)layer * D * NMOD + c0 + 4 * cgp;
        f32x4 acc[5];
#pragma unroll
        for (int b = 0; b < 5; ++b) acc[b] = (f32x4){0.f, 0.f, 0.f, 0.f};
#pragma unroll 4
        for (int i = 0; i < 16; ++i) {
            const int k = 128 * wave + 8 * i + kk;
            const f32x4 wv = *(const f32x4*)(W + (size_t)k * NMOD);
#pragma unroll
            for (int b = 0; b < 5; ++b) acc[b] += wv * S[b * D + k];
        }
#pragma unroll
        for (int b = 0; b < 5; ++b)
#pragma unroll
            for (int e = 0; e < 4; ++e) { float v = acc[b][e]; v += __shfl_xor(v, 8); v += __shfl_xor(v, 16); v += __shfl_xor(v, 32); acc[b][e] = v; }
        if (lane < 8) {
#pragma unroll
            for (int b = 0; b < 5; ++b)
#pragma unroll
                for (int e = 0; e < 4; ++e) red[(wave * 5 + b) * 32 + 4 * cgp + e] = acc[b][e];
        }
        __syncthreads();
        if (tid < 160) { const int b = tid >> 5, cc = tid & 31; float s = P.adaln_b[(size_t)layer * NMOD + c0 + cc];
#pragma unroll
            for (int w = 0; w < 8; ++w) s += red[(w * 5 + b) * 32 + cc];
            mods[((size_t)layer * 5 + b) * NMOD + c0 + cc] = s; }
        __syncthreads();
    }
    LAS float* scr = (LAS float*)(lds + wave * 16384);
    const int gw = blockIdx.x * NWAVES + wave, NGW = gridDim.x * NWAVES;
    constexpr int I_QKV = 16 * 96, I_WO = 16 * 32, I_POOL = 4 * 8, I_W1 = 16 * 88, I_W2 = 44 * 32;
    constexpr int T_QKV = 2 * I_QKV, T_WO = 2 * I_WO, T_SCIN = I_QKV, T_SCOUT = I_WO, T_POOL = 4 * I_POOL, T_W1 = 4 * I_W1, T_W3 = 4 * I_W1, T_W2 = 4 * I_W2;
    constexpr int NITEMS = T_QKV + T_WO + T_SCIN + T_SCOUT + T_POOL + T_W1 + T_W3 + T_W2;
    for (int it = gw; it < NITEMS; it += NGW) {
        int r = it;
        if (r < T_QKV) { const int l = r / I_QKV, q = r % I_QKV, kb = q / 96, nb = q % 96;
            transpose_item(P.na_w_qkv + (size_t)l * D * 3 * D, 3 * D, 64 * kb, 32 * nb, (bf16_t*)(ws + WS_WQKV) + (size_t)l * 3 * D * D, D, 32 * nb, scr, lane); continue; } r -= T_QKV;
        if (r < T_WO) { const int l = r / I_WO, q = r % I_WO, kb = q / 32, nb = q % 32;
            transpose_item(P.na_w_o + (size_t)l * D * D, D, 64 * kb, 32 * nb, (bf16_t*)(ws + WS_WO) + (size_t)l * D * D, D, 32 * nb, scr, lane); continue; } r -= T_WO;
        if (r < T_SCIN) { const int kb = r / 96, nb = r % 96, n0 = 32 * nb;
            int rb; if (n0 < D) rb = n0; else if (n0 < 2 * D) { const int j = n0 - D; rb = D + (j / 128) * 256 + (j % 128); } else { const int j = n0 - 2 * D; rb = D + (j / 128) * 256 + 128 + (j % 128); }
            transpose_item(P.sc_w_in, 3 * D, 64 * kb, n0, (bf16_t*)(ws + WS_WSCIN), D, rb, scr, lane); continue; } r -= T_SCIN;
        if (r < T_SCOUT) { const int kb = r / 32, nb = r % 32;
            transpose_item(P.sc_w_out, D, 64 * kb, 32 * nb, (bf16_t*)(ws + WS_WSCOUT), D, 32 * nb, scr, lane); continue; } r -= T_SCOUT;
        if (r < T_POOL) { const int g = r / I_POOL, q = r % I_POOL, kb = q / 8, nb = q % 8;
            transpose_item(P.pool_w + (size_t)g * 256 * 256, 256, 64 * kb, 32 * nb, (bf16_t*)(ws + WS_WPOOL) + (size_t)g * 256 * 256, 256, 32 * nb, scr, lane); continue; } r -= T_POOL;
        if (r < T_W1 + T_W3) { const int which = r / T_W1; r -= which * T_W1; const int l = r / I_W1, q = r % I_W1, kb = q / 88, nb = q % 88, n0 = 32 * nb;
            const float* src = (which ? P.ffn_w3 : P.ffn_w1) + (size_t)l * D * FF;
            transpose_item(src, FF, 64 * kb, n0, (bf16_t*)(ws + WS_W13) + (size_t)l * 2 * FF * D, D, (n0 / 128) * 256 + which * 128 + (n0 % 128), scr, lane); continue; } r -= T_W1 + T_W3;
        { const int l = r / I_W2, q = r % I_W2, kb = q / 32, nb = q % 32;
            transpose_item(P.ffn_w2 + (size_t)l * FF * D, D, 64 * kb, 32 * nb, (bf16_t*)(ws + WS_W2) + (size_t)l * D * FF, FF, 32 * nb, scr, lane); }
    }
}

__device__ __forceinline__ void norm_phase(const float* src_lat, const float* src_ctx, const float* g, const float* mods_l, int shift_i, int scale_i, bf16_t* H, int nrows) {
    const int tid = opaque_tid(), lane = tid & 63, wave = __builtin_amdgcn_readfirstlane(tid >> 6);
    const int gw = blockIdx.x * NWAVES + wave, NGW = gridDim.x * NWAVES;
    for (int m = gw; m < nrows; m += NGW) {
        const float* xr = m < MLAT ? src_lat + (size_t)m * D : src_ctx + (size_t)(m - MLAT) * D;
        const int mb = m < MLAT ? (m >> 12) : 4;
        const float* sh = mods_l + (size_t)mb * NMOD + shift_i * D; const float* sc = mods_l + (size_t)mb * NMOD + scale_i * D;
        f32x4 v[4]; float s = 0.f;
#pragma unroll
        for (int j = 0; j < 4; ++j) { v[j] = *(const f32x4*)(xr + 4 * lane + 256 * j); s += (v[j][0] * v[j][0] + v[j][1] * v[j][1]) + (v[j][2] * v[j][2] + v[j][3] * v[j][3]); }
        const float rstd = 1.0f / sqrtf(wave_sum(s) * (1.0f / D) + EPS);
#pragma unroll
        for (int j = 0; j < 4; ++j) { const int c = 4 * lane + 256 * j;
            const f32x4 gv = *(const f32x4*)(g + c), scv = *(const f32x4*)(sc + c), shv = *(const f32x4*)(sh + c);
            const f32x4 o = (v[j] * rstd) * gv * (scv + 1.0f) + shv;
            u32x2 w; w.x = cvt_pk_bf16(o[0], o[1]); w.y = cvt_pk_bf16(o[2], o[3]);
            *(u32x2*)(H + (size_t)m * D + c) = w; }
    }
}
__device__ __forceinline__ void final_norm_phase(const float* X, const float* g, float* out) {
    const int tid = opaque_tid(), lane = tid & 63, wave = __builtin_amdgcn_readfirstlane(tid >> 6);
    const int gw = blockIdx.x * NWAVES + wave, NGW = gridDim.x * NWAVES;
    for (int m = gw; m < MLAT; m += NGW) {
        const float* xr = X + (size_t)m * D;
        f32x4 v[4]; float s = 0.f;
#pragma unroll
        for (int j = 0; j < 4; ++j) { v[j] = *(const f32x4*)(xr + 4 * lane + 256 * j); s += (v[j][0] * v[j][0] + v[j][1] * v[j][1]) + (v[j][2] * v[j][2] + v[j][3] * v[j][3]); }
        const float rstd = 1.0f / sqrtf(wave_sum(s) * (1.0f / D) + EPS);
#pragma unroll
        for (int j = 0; j < 4; ++j) { const int c = 4 * lane + 256 * j; *(f32x4*)(out + (size_t)m * D + c) = (v[j] * rstd) * *(const f32x4*)(g + c); }
    }
}

__device__ __forceinline__ void pool_phase(const float* X, const float* g, const float* mods_l, bf16_t* Pq, LAS float* rs) {
    const int tid = opaque_tid(), lane = tid & 63, wave = __builtin_amdgcn_readfirstlane(tid >> 6);
    for (int ch = blockIdx.x; ch < MTOT / 16; ch += gridDim.x) {
        const int m0 = ch * 16; int s0, s1, mb;
        if (m0 < MLAT) { s0 = m0 & ~4095; s1 = s0 + 4096; mb = m0 >> 12; } else { s0 = MLAT + ((m0 - MLAT) & ~255); s1 = s0 + 256; mb = 4; }
        const int lo = max(m0 - 8, s0), hi = min(m0 + 24, s1);
        for (int r = lo + wave; r < hi; r += NWAVES) {
            const float* xr = X + (size_t)r * D; float s = 0.f;
#pragma unroll
            for (int j = 0; j < 4; ++j) { const f32x4 v = *(const f32x4*)(xr + 4 * lane + 256 * j); s += (v[0] * v[0] + v[1] * v[1]) + (v[2] * v[2] + v[3] * v[3]); }
            const float rstd = 1.0f / sqrtf(wave_sum(s) * (1.0f / D) + EPS);
            if (lane == 0) rs[r - lo] = rstd;
        }
        __syncthreads();
        const int c = 2 * tid, hw = 1 << (c >> 8);
        const f32x2 gv = *(const f32x2*)(g + c), scv = *(const f32x2*)(mods_l + (size_t)mb * NMOD + 1 * D + c);
        const f32x2 Gv = gv * (scv + 1.0f);
        int wl = max(m0 - hw, s0), wh = min(m0 + hw, s1);
        f32x2 sum = (f32x2){0.f, 0.f};
        for (int r = wl; r < wh; ++r) sum += *(const f32x2*)(X + (size_t)r * D + c) * rs[r - lo];
        for (int t = m0; t < m0 + 16; ++t) {
            if (t > m0) {
                const int nl = max(t - hw, s0), nh = min(t + hw, s1);
                if (nh > wh) { sum += *(const f32x2*)(X + (size_t)wh * D + c) * rs[wh - lo]; wh = nh; }
                if (nl > wl) { sum -= *(const f32x2*)(X + (size_t)wl * D + c) * rs[wl - lo]; wl = nl; }
            }
            const float inv = 1.0f / (float)(wh - wl);
            const f32x2 xc = *(const f32x2*)(X + (size_t)t * D + c) * rs[t - lo];
            const f32x2 p = (sum * inv - xc) * Gv;
            *(unsigned*)(Pq + (size_t)t * D + c) = cvt_pk_bf16(p[0], p[1]);
        }
        __syncthreads();
    }
}

__device__ __forceinline__ void conv_phase(const bf16_t* GB, const bf16_t* U, const float* cw, bf16_t* Z) {
    const int tid = opaque_tid();
    const long total = (long)MTOT * 128, nth = (long)gridDim.x * NTHREADS;
    for (long idx = (long)blockIdx.x * NTHREADS + tid; idx < total; idx += nth) {
        const int m = (int)(idx >> 7), c8 = (int)(idx & 127) * 8;
        const int pos = m < MLAT ? (m & 4095) : ((m - MLAT) & 255), len = m < MLAT ? 4096 : 256;
        const u32x4 zero = (u32x4){0u, 0u, 0u, 0u};
        const u32x4 g4 = *(const u32x4*)(GB + (size_t)m * D + c8), u0 = *(const u32x4*)(U + (size_t)m * D + c8);
        const u32x4 um = pos > 0 ? *(const u32x4*)(U + (size_t)(m - 1) * D + c8) : zero;
        const u32x4 up = pos < len - 1 ? *(const u32x4*)(U + (size_t)(m + 1) * D + c8) : zero;
        float o[8];
#pragma unroll
        for (int e = 0; e < 4; ++e) {
            const int c = c8 + 2 * e;
            const f32x2 w0 = *(const f32x2*)(cw + c), w1 = *(const f32x2*)(cw + D + c), w2 = *(const f32x2*)(cw + 2 * D + c);
            o[2 * e] = bf_lo(g4[e]) * (bf_lo(um[e]) * w0[0] + bf_lo(u0[e]) * w1[0] + bf_lo(up[e]) * w2[0]);
            o[2 * e + 1] = bf_hi(g4[e]) * (bf_hi(um[e]) * w0[1] + bf_hi(u0[e]) * w1[1] + bf_hi(up[e]) * w2[1]);
        }
        u32x4 w; w.x = cvt_pk_bf16(o[0], o[1]); w.y = cvt_pk_bf16(o[2], o[3]); w.z = cvt_pk_bf16(o[4], o[5]); w.w = cvt_pk_bf16(o[6], o[7]);
        *(u32x4*)(Z + (size_t)m * D + c8) = w;
    }
}

__device__ __forceinline__ void attn_naive_phase(const bf16_t* Q, const bf16_t* Kb, const bf16_t* VT, bf16_t* O, const float* rpb, LAS float* pl_all, int nrows) {
    const int tid = opaque_tid(), lane = tid & 63, wave = __builtin_amdgcn_readfirstlane(tid >> 6);
    const int gw = blockIdx.x * NWAVES + wave, NGW = gridDim.x * NWAVES;
    LAS float* pl = pl_all + wave * 384;
    for (long task = gw; task < (long)nrows * NH; task += NGW) {
        const int m = (int)(task >> 4), h = (int)(task & 15);
        const bool lat = m < MLAT; const int b = lat ? (m >> 12) : ((m - MLAT) >> 8);
        int r = 0, qc = 0, start = 0, cs = 0;
        if (lat) { const int t = m & 4095; r = t >> 6; qc = t & 63; start = min(max(r - 4, 0), 56); cs = min(max(qc - 8, 0), 48); }
        const int ctxbase = MLAT + b * 256;
        u32x4 qv[8];
#pragma unroll
        for (int i = 0; i < 8; ++i) qv[i] = *(const u32x4*)(Q + (size_t)m * D + h * 64 + 8 * i);
        float s[6];
#pragma unroll
        for (int i = 0; i < 6; ++i) {
            int tok = 0; float bias = 0.f; bool valid = true;
            if (i < 2) {
                if (!lat) valid = false;
                else { const int j = lane + 64 * i, kr = start + (j >> 4), kc = cs + (j & 15); tok = b * 4096 + kr * 64 + kc;
                    bias = rpb[(h * 15 + (kr - r + 7)) * 31 + (kc - qc + 15)] * LOG2E; }
            } else tok = ctxbase + lane + 64 * (i - 2);
            float dot = 0.f;
            if (valid) {
                const bf16_t* kp = Kb + (size_t)tok * D + h * 64;
#pragma unroll
                for (int ii = 0; ii < 8; ++ii) { const u32x4 kv = *(const u32x4*)(kp + 8 * ii);
#pragma unroll
                    for (int e = 0; e < 4; ++e) dot += bf_lo(qv[ii][e]) * bf_lo(kv[e]) + bf_hi(qv[ii][e]) * bf_hi(kv[e]); }
                s[i] = dot + bias;
            } else s[i] = -INFINITY;
        }
        float mx = s[0];
#pragma unroll
        for (int i = 1; i < 6; ++i) mx = fmaxf(mx, s[i]);
        mx = wave_max(mx);
        float sum = 0.f;
#pragma unroll
        for (int i = 0; i < 6; ++i) { const float p = exp2f(s[i] - mx); sum += p; pl[lane + 64 * i] = p; }
        sum = wave_sum(sum);
        __builtin_amdgcn_wave_barrier();
        asm volatile("s_waitcnt lgkmcnt(0)" ::: "memory");
        const bf16_t* vrow = VT + (size_t)(h * 64 + lane) * MTOT;
        float o = 0.f;
        if (lat) {
            for (int j = 0; j < 128; ++j) { const int tok = b * 4096 + (start + (j >> 4)) * 64 + cs + (j & 15); o += pl[j] * bf2f(vrow[tok]); }
        }
        for (int l8 = 0; l8 < 32; ++l8) {
            const u32x4 vv = *(const u32x4*)(vrow + ctxbase + 8 * l8);
#pragma unroll
            for (int e = 0; e < 4; ++e) o += pl[128 + 8 * l8 + 2 * e] * bf_lo(vv[e]) + pl[128 + 8 * l8 + 2 * e + 1] * bf_hi(vv[e]);
        }
        const float res = o / sum;
        O[(size_t)m * D + h * 64 + lane] = (bf16_t)(cvt_pk_bf16(res, 0.f) & 0xffffu);
        __builtin_amdgcn_wave_barrier();
        asm volatile("s_waitcnt lgkmcnt(0)" ::: "memory");
    }
}


typedef float f32x16 __attribute__((ext_vector_type(16)));
constexpr int RPB_PAD = 64, RPB_N = NH * 15 * 31;
template <bool BAND>
__device__ __forceinline__ void attn_tile(const bf16_t* Kt, const bf16_t* Vt, const bf16x8 (&qr)[4], float& mref, float& l, f32x16& o0, f32x16& o1,
                                          const LAS float* brow, int lo, int r32, int hi) {
    bf16x8 kf[2][4];
#pragma unroll
    for (int p = 0; p < 2; ++p)
#pragma unroll
        for (int d0 = 0; d0 < 4; ++d0) kf[p][d0] = *(const bf16x8*)(Kt + (size_t)(r32 + 32 * p) * D + 16 * d0 + 8 * hi);
    u32x2 va[2][4], vb[2][4];
#pragma unroll
    for (int dh = 0; dh < 2; ++dh)
#pragma unroll
        for (int sl = 0; sl < 4; ++sl) { const bf16_t* vp = Vt + (size_t)(r32 + 32 * dh) * MTOT + 16 * sl + 4 * hi; va[dh][sl] = *(const u32x2*)vp; vb[dh][sl] = *(const u32x2*)(vp + 8); }
    f32x16 p0, p1;
#pragma unroll
    for (int r = 0; r < 16; ++r) { p0[r] = 0.f; p1[r] = 0.f; }
#pragma unroll
    for (int d0 = 0; d0 < 4; ++d0) { p0 = __builtin_amdgcn_mfma_f32_32x32x16_bf16(kf[0][d0], qr[d0], p0, 0, 0, 0); p1 = __builtin_amdgcn_mfma_f32_32x32x16_bf16(kf[1][d0], qr[d0], p1, 0, 0, 0); }
    if (BAND) {
#pragma unroll
        for (int r = 0; r < 16; ++r) { const int C0 = (r & 3) + 8 * (r >> 2);
            p0[r] = ((unsigned)(C0 - lo) < 16u) ? p0[r] + brow[C0] : -INFINITY;
            p1[r] = ((unsigned)(C0 + 32 - lo) < 16u) ? p1[r] + brow[C0 + 32] : -INFINITY; }
    }
    float mt = fmaxf(p0[0], p1[0]);
#pragma unroll
    for (int r = 1; r < 16; ++r) mt = fmaxf(mt, fmaxf(p0[r], p1[r]));
    mt = fmaxf(mt, __shfl_xor(mt, 32));
    if (__any(mt > mref + 8.0f)) {
        const float mnew = (mt > mref + 8.0f) ? mt : mref;
        const float alpha = __builtin_amdgcn_exp2f(mref - mnew);
        l *= alpha;
#pragma unroll
        for (int r = 0; r < 16; ++r) { o0[r] *= alpha; o1[r] *= alpha; }
        mref = mnew;
    }
    float ls = 0.f;
#pragma unroll
    for (int r = 0; r < 16; ++r) { p0[r] = __builtin_amdgcn_exp2f(p0[r] - mref); p1[r] = __builtin_amdgcn_exp2f(p1[r] - mref); ls += p0[r] + p1[r]; }
    l += ls;
    bf16x8 pf[4];
#pragma unroll
    for (int sl = 0; sl < 4; ++sl) {
        u32x4 w;
        if (sl < 2) { const int o = 8 * sl; w.x = cvt_pk_bf16(p0[o], p0[o + 1]); w.y = cvt_pk_bf16(p0[o + 2], p0[o + 3]); w.z = cvt_pk_bf16(p0[o + 4], p0[o + 5]); w.w = cvt_pk_bf16(p0[o + 6], p0[o + 7]); }
        else { const int o = 8 * (sl - 2); w.x = cvt_pk_bf16(p1[o], p1[o + 1]); w.y = cvt_pk_bf16(p1[o + 2], p1[o + 3]); w.z = cvt_pk_bf16(p1[o + 4], p1[o + 5]); w.w = cvt_pk_bf16(p1[o + 6], p1[o + 7]); }
        pf[sl] = __builtin_bit_cast(bf16x8, w);
    }
#pragma unroll
    for (int sl = 0; sl < 4; ++sl) {
        const u32x4 a0 = (u32x4){va[0][sl].x, va[0][sl].y, vb[0][sl].x, vb[0][sl].y}, a1 = (u32x4){va[1][sl].x, va[1][sl].y, vb[1][sl].x, vb[1][sl].y};
        o0 = __builtin_amdgcn_mfma_f32_32x32x16_bf16(__builtin_bit_cast(bf16x8, a0), pf[sl], o0, 0, 0, 0);
        o1 = __builtin_amdgcn_mfma_f32_32x32x16_bf16(__builtin_bit_cast(bf16x8, a1), pf[sl], o1, 0, 0, 0);
    }
}
__device__ __forceinline__ void attn_unit(const bf16_t* Q, const bf16_t* Kb, const bf16_t* VT, bf16_t* O, const LAS float* tab, int b, int h, int m0, bool lat, int r, int qc0, int lane) {
    const int r32 = lane & 31, hi = lane >> 5;
    bf16x8 qr[4];
#pragma unroll
    for (int d0 = 0; d0 < 4; ++d0) qr[d0] = *(const bf16x8*)(Q + (size_t)(m0 + r32) * D + h * 64 + 16 * d0 + 8 * hi);
    float mref = -INFINITY, l = 0.f; f32x16 o0, o1;
#pragma unroll
    for (int i = 0; i < 16; ++i) { o0[i] = 0.f; o1[i] = 0.f; }
    const bf16_t* Vh = VT + (size_t)(h * 64) * MTOT;
    const int ctxbase = MLAT + b * 256;
    for (int ti = 0; ti < 4; ++ti) {
        const int tok0 = ctxbase + 64 * ti;
        attn_tile<false>(Kb + (size_t)tok0 * D + h * 64, Vh + tok0, qr, mref, l, o0, o1, tab, 0, r32, hi);
    }
    if (lat) {
        const int qc = qc0 + r32, cs = min(max(qc - 8, 0), 48), start = min(max(r - 4, 0), 56);
        const int lo = cs - 4 * hi;
        const LAS float* lb = tab + RPB_PAD + h * 15 * 31 + (4 * hi - qc + 15);
        for (int ti = 0; ti < 8; ++ti) {
            const int kr = start + ti, tok0 = b * 4096 + kr * 64;
            attn_tile<true>(Kb + (size_t)tok0 * D + h * 64, Vh + tok0, qr, mref, l, o0, o1, lb + (kr - r + 7) * 31, lo, r32, hi);
        }
    }
    l += __shfl_xor(l, 32);
    const float inv = 1.0f / l;
    bf16_t* op = O + (size_t)(m0 + r32) * D + h * 64 + 4 * hi;
#pragma unroll
    for (int g = 0; g < 4; ++g) {
        u32x2 w0, w1;
        w0.x = cvt_pk_bf16(o0[4 * g] * inv, o0[4 * g + 1] * inv); w0.y = cvt_pk_bf16(o0[4 * g + 2] * inv, o0[4 * g + 3] * inv);
        w1.x = cvt_pk_bf16(o1[4 * g] * inv, o1[4 * g + 1] * inv); w1.y = cvt_pk_bf16(o1[4 * g + 2] * inv, o1[4 * g + 3] * inv);
        *(u32x2*)(op + 8 * g) = w0; *(u32x2*)(op + 32 + 8 * g) = w1;
    }
}
__device__ __forceinline__ void attn_phase(const bf16_t* Q, const bf16_t* Kb, const bf16_t* VT, bf16_t* O, const float* rpb, LAS float* tab, int nrows) {
    const int tid = opaque_tid(), lane = tid & 63, wave = __builtin_amdgcn_readfirstlane(tid >> 6);
    for (int i = tid; i < RPB_N + 2 * RPB_PAD; i += NTHREADS) { const int k = i - RPB_PAD; tab[i] = (k >= 0 && k < RPB_N) ? rpb[k] * LOG2E : 0.f; }
    __syncthreads();
    for (int wi = blockIdx.x; wi < 256; wi += gridDim.x) {
        const int bh = wi >> 2, rg = wi & 3, b = bh >> 4, h = bh & 15;
        for (int u = 0; u < 4; ++u) {
            const int r = rg * 16 + 2 * wave + (u >> 1), half = u & 1;
            attn_unit(Q, Kb, VT, O, tab, b, h, b * 4096 + r * 64 + 32 * half, true, r, 32 * half, lane);
        }
    }
    if (nrows == MTOT) {
        const int gw = blockIdx.x * NWAVES + wave, NGW = gridDim.x * NWAVES;
        for (int cu = gw; cu < 2048; cu += NGW) {
            if ((cu & 3) == 0) { const int un = cu >> 2, b = un >> 7, h = (un >> 3) & 15, blk = un & 7;
                attn_unit(Q, Kb, VT, O, tab, b, h, MLAT + b * 256 + blk * 32, false, 0, 0, lane); }
        }
    }
    __syncthreads();
}

__global__ void __launch_bounds__(NTHREADS, 2) mk_fwd(Args P) {
    extern __shared__ __attribute__((aligned(16))) unsigned char lds_raw[];
    LAS unsigned char* lds = (LAS unsigned char*)lds_raw;
    cg::grid_group grid = cg::this_grid();
    if (threadIdx.x < 2) ((volatile LAS unsigned*)(lds + LDS_MISC_OFF))[threadIdx.x] = 0u;
    __syncthreads();
    const XcdBarrier xbar = xcd_barrier_post((unsigned*)(P.ws + WS_CTL), (volatile LAS unsigned*)(lds + LDS_MISC_OFF));
#define GSYNC() do { xcd_barrier(xbar); for (int _e = 0; _e < EXP_SYNC; ++_e) xcd_barrier(xbar); } while (0)
    const int G = gridDim.x, bx = blockIdx.x;
    unsigned char* ws = P.ws;
    float* mods = (float*)(ws + WS_MODS);
    float* X = (float*)(ws + WS_X);
    bf16_t* H = (bf16_t*)(ws + WS_H);
    bf16_t* Qb = (bf16_t*)(ws + WS_Q); bf16_t* Kb = (bf16_t*)(ws + WS_K); bf16_t* VT = (bf16_t*)(ws + WS_VT); bf16_t* Ob = (bf16_t*)(ws + WS_O);
    bf16_t* Gb = (bf16_t*)(ws + WS_G);
    constexpr size_t TS1024 = (size_t)256 * 1024 * 2;

    for (int _e = 0; _e <= EXP_PRO; ++_e) { prologue_phase(P, lds); __syncthreads(); }
    grid.sync();

    for (int layer = 0; layer < NLAYER; ++layer) {
        const int kind = layer % 3, j = layer / 3;
        const bool lastl = (layer == NLAYER - 1);
        const int nrows = lastl ? MLAT : MTOT;
        const float* mods_l = mods + (size_t)layer * 5 * NMOD;
        const float* xin_lat = layer == 0 ? P.x : X;
        const float* xin_ctx = layer == 0 ? P.ctx : X + (size_t)MLAT * D;

        if (kind == 0) {
            norm_phase(xin_lat, xin_ctx, P.norm_mix_g + layer * D, mods_l, 0, 1, H, MTOT);
            GSYNC();
            {
                const bf16_t* Wt = (const bf16_t*)(ws + WS_WQKV) + (size_t)j * 3 * D * D;
                pg8::Sched S; S.init1(H, TS1024, Wt, TS1024, MTOT / 256, 8, G, bx);
                S.add2(Wt + (size_t)2 * D * D, TS1024, H, TS1024, 4, MTOT / 256);
                pg8::EpiQKV E{Qb, Kb, VT};
                pg8::gemm_phase<pg8::EpiQKV>(lds, D, D, D, S, E);
            }
            GSYNC();
            for (int _e = 0; _e <= EXP_ATTN; ++_e) attn_phase(Qb, Kb, VT, Ob, P.na_rpb + (size_t)j * NH * 15 * 31, (LAS float*)lds, nrows);
            GSYNC();
            {
                const bf16_t* Wt = (const bf16_t*)(ws + WS_WO) + (size_t)j * D * D;
                pg8::Sched S; S.init1(Ob, TS1024, Wt, TS1024, nrows / 256, 4, G, bx);
                pg8::EpiRes E{xin_lat, xin_ctx, X, mods_l + 2 * D, nullptr};
                pg8::gemm_phase<pg8::EpiRes>(lds, D, D, D, S, E);
            }
            GSYNC();
        } else if (kind == 1) {
            norm_phase(xin_lat, xin_ctx, P.norm_mix_g + layer * D, mods_l, 0, 1, H, MTOT);
            GSYNC();
            {
                const bf16_t* Wt = (const bf16_t*)(ws + WS_WSCIN);
                pg8::Sched S; S.init1(H, TS1024, Wt, TS1024, MTOT / 256, 12, G, bx);
                pg8::EpiSCin E{Qb, Kb};
                pg8::gemm_phase<pg8::EpiSCin>(lds, D, D, D, S, E);
            }
            GSYNC();
            conv_phase(Qb, Kb, P.sc_conv_w + (size_t)j * 3 * D, Ob);
            GSYNC();
            {
                const bf16_t* Wt = (const bf16_t*)(ws + WS_WSCOUT);
                pg8::Sched S; S.init1(Ob, TS1024, Wt, TS1024, nrows / 256, 4, G, bx);
                pg8::EpiRes E{xin_lat, xin_ctx, X, mods_l + 2 * D, nullptr};
                pg8::gemm_phase<pg8::EpiRes>(lds, D, D, D, S, E);
            }
            GSYNC();
        } else {
            pool_phase(X, P.norm_mix_g + layer * D, mods_l, H, (LAS float*)lds);
            GSYNC();
            {
                const bf16_t* Wt = (const bf16_t*)(ws + WS_WPOOL);
                pg8::Sched S; S.init1(H, TS1024, Wt, (size_t)256 * 256 * 2, nrows / 256, 4, G, bx); S.apn = 512;
                pg8::EpiRes E{xin_lat, xin_ctx, X, mods_l + 2 * D, P.pool_scale + (size_t)j * D};
                pg8::gemm_phase<pg8::EpiRes>(lds, 256, D, 256, S, E);
            }
            GSYNC();
        }
        for (int _e = 0; _e <= EXP_NORM; ++_e) norm_phase(X, X + (size_t)MLAT * D, P.norm_ffn_g + layer * D, mods_l, 3, 4, H, nrows);
        GSYNC();
        {
            const bf16_t* Wt = (const bf16_t*)(ws + WS_W13) + (size_t)layer * 2 * FF * D;
            pg8::Sched S; S.init1(H, TS1024, Wt, TS1024, nrows / 256, 2 * FF / 256, G, bx);
            pg8::EpiSwi E{Gb};
            for (int _e = 0; _e <= EXP_UP; ++_e) pg8::gemm_phase<pg8::EpiSwi>(lds, D, D, D, S, E);
        }
        GSYNC();
        {
            const bf16_t* Wt = (const bf16_t*)(ws + WS_W2) + (size_t)layer * D * FF;
            pg8::Sched S; S.init1(Gb, (size_t)256 * FF * 2, Wt, (size_t)256 * FF * 2, nrows / 256, 4, G, bx);
            pg8::EpiRes E{X, X + (size_t)MLAT * D, X, mods_l + 5 * D, nullptr};
            pg8::gemm_phase<pg8::EpiRes>(lds, FF, FF, FF, S, E);
        }
        GSYNC();
    }
    final_norm_phase(X, P.final_g, P.out);
}

extern "C" void kernel_launch(void* const* d_in, const int* in_sizes, int n_in, void* d_out, int out_size, void* d_ws, size_t ws_size, hipStream_t stream) {
    static int grid = 0;
    if (grid == 0) {
        if (n_in != 20 || ws_size < WS_END) { fprintf(stderr, "kernel_launch: unexpected n_in %d / ws_size %zu\n", n_in, ws_size); grid = -1; return; }
        int dev = 0, cus = 0, per_cu = 0;
        hipGetDevice(&dev);
        hipDeviceGetAttribute(&cus, hipDeviceAttributeMultiprocessorCount, dev);
        if (hipFuncSetAttribute((const void*)mk_fwd, hipFuncAttributeMaxDynamicSharedMemorySize, LDS_BYTES) != hipSuccess) { fprintf(stderr, "kernel_launch: hipFuncSetAttribute failed\n"); }
        if (hipOccupancyMaxActiveBlocksPerMultiprocessor(&per_cu, (const void*)mk_fwd, NTHREADS, LDS_BYTES) != hipSuccess || per_cu < 1) { fprintf(stderr, "kernel_launch: occupancy query says %d\n", per_cu); per_cu = 1; }
        (void)hipGetLastError();
        grid = cus * 1;
        if (grid <= 0) grid = 256;
    }
    if (grid < 0) return;
    if (hipMemsetAsync((char*)d_ws + WS_CTL, 0, CTL_ZERO_BYTES, stream) != hipSuccess) { fprintf(stderr, "kernel_launch: memset failed\n"); return; }
    Args a{};
    const float** f = (const float**)&a;
    for (int i = 0; i < 20; ++i) f[i] = (const float*)d_in[i];
    a.out = (float*)d_out; a.ws = (unsigned char*)d_ws;
    void* args[] = {&a};
    hipError_t e = hipLaunchCooperativeKernel((const void*)mk_fwd, dim3(grid), dim3(NTHREADS), args, LDS_BYTES, stream);
    if (e != hipSuccess) fprintf(stderr, "cooperative launch failed: %s (grid %d)\n", hipGetErrorString(e), grid);
}
```

```cpp
#include <hip/hip_runtime.h>
#include <hip/hip_cooperative_groups.h>
#include <cstdio>
#include <cstdint>
namespace cg = cooperative_groups;

#define LAS __attribute__((address_space(3)))
typedef unsigned short bf16_t;
typedef short bf16x8 __attribute__((ext_vector_type(8)));
typedef float f32x4 __attribute__((ext_vector_type(4)));
typedef float f32x2 __attribute__((ext_vector_type(2)));
typedef unsigned u32x4 __attribute__((ext_vector_type(4)));
typedef unsigned u32x2 __attribute__((ext_vector_type(2)));

constexpr int D = 1024, NB = 4, SEQ = 4096, CTXL = 256, NLAYER = 4, FF = 2816, NH = 16, HD = 64;
constexpr int MLAT = NB * SEQ, MCTX = NB * CTXL, MTOT = MLAT + MCTX;
constexpr int NMOD = 6 * D;
constexpr float EPS = 1e-6f;
constexpr float LOG2E = 1.4426950408889634f;
constexpr float QSCALE = 0.125f * LOG2E;

constexpr size_t MiB = 1u << 20;
constexpr size_t WS_MODS = 0;
constexpr size_t WS_WQKV = 1 * MiB;
constexpr size_t WS_WO = 13 * MiB;
constexpr size_t WS_WSCIN = 17 * MiB;
constexpr size_t WS_WSCOUT = 23 * MiB;
constexpr size_t WS_WPOOL = 25 * MiB;
constexpr size_t WS_W13 = 26 * MiB;
constexpr size_t WS_W2 = 70 * MiB;
constexpr size_t WS_X = 92 * MiB;
constexpr size_t WS_H = 160 * MiB;
constexpr size_t WS_Q = 194 * MiB;
constexpr size_t WS_K = 228 * MiB;
constexpr size_t WS_VT = 262 * MiB;
constexpr size_t WS_O = 296 * MiB;
constexpr size_t WS_G = 194 * MiB;
constexpr size_t WS_CTL = 330 * MiB;
constexpr size_t CTL_ZERO_BYTES = 65536;
constexpr size_t WS_END = 331 * MiB;
static_assert(WS_G + (size_t)MTOT * FF * 2 <= WS_O, "G overlay");

#ifndef EXP_SYNC
#define EXP_SYNC 0
#endif
#ifndef EXP_ATTN
#define EXP_ATTN 0
#endif
#ifndef EXP_PRO
#define EXP_PRO 0
#endif
#ifndef EXP_NORM
#define EXP_NORM 0
#endif
#ifndef EXP_UP
#define EXP_UP 0
#endif
constexpr int LDS_BYTES = 147456;
constexpr int LDS_MISC_OFF = 131072 + 1024;
constexpr int NWAVES = 8, NTHREADS = 512;

__device__ __forceinline__ int opaque_tid() { int t = threadIdx.x; asm volatile("" : "+v"(t)); return t; }
__device__ __forceinline__ unsigned cvt_pk_bf16(float lo, float hi) { unsigned r; asm volatile("v_cvt_pk_bf16_f32 %0, %1, %2" : "=v"(r) : "v"(lo), "v"(hi)); return r; }
__device__ __forceinline__ float bf_lo(unsigned w) { return __uint_as_float(w << 16); }
__device__ __forceinline__ float bf_hi(unsigned w) { return __uint_as_float(w & 0xffff0000u); }
__device__ __forceinline__ float bf2f(bf16_t v) { return __uint_as_float(((unsigned)v) << 16); }
__device__ __forceinline__ float silu_f(float x) { return x * __builtin_amdgcn_rcpf(1.0f + __expf(-x)); }
__device__ __forceinline__ float wave_sum(float v) {
#pragma unroll
    for (int o = 1; o < 64; o <<= 1) v += __shfl_xor(v, o);
    return v;
}
__device__ __forceinline__ float wave_max(float v) {
#pragma unroll
    for (int o = 1; o < 64; o <<= 1) v = fmaxf(v, __shfl_xor(v, o));
    return v;
}

namespace pg8 {
constexpr int BM = 256, BK = 64, HALF = 128, HTB = HALF * BK * 2, STAGE_BYTES = 8 * HTB, NXCD = 8, WGM = 8;
__host__ __device__ __forceinline__ int lds_byte(int r, int c) { const int st = (r >> 4) * 2 + (c >> 5), rr = r & 15, cc = c & 31, ob = rr * 64 + cc * 2; return st * 1024 + (ob ^ (((ob >> 9) & 1) << 5)); }
__host__ __device__ __forceinline__ void stage_rc(int b, int& R, int& C) { const int st = b / 1024, sb = b % 1024, swz = sb ^ (((sb >> 9) & 1) << 5); R = (st >> 1) * 16 + swz / 64; C = (st & 1) * 32 + (swz % 64) / 2; }
__host__ __device__ __forceinline__ int perm32(int rho) { const int n = rho >> 4, i = rho & 15; return 8 * (i >> 2) + 4 * n + (i & 3); }

struct Unit { const char* a; const char* b; int pm, pn, fam; };

struct Sched {
    const char* A1; const char* B1; size_t tsA1, tsB1, apn; int nM1, nN1, nwg1;
    const char* A2; const char* B2; size_t tsA2, tsB2; int nM2, nN2;
    int nwg, G, c;
    __device__ void init1(const void* A, size_t tsA, const void* B, size_t tsB, int nM, int nN, int G_, int c_) {
        A1 = (const char*)A; B1 = (const char*)B; tsA1 = tsA; tsB1 = tsB; apn = 0; nM1 = nM; nN1 = nN; nwg1 = nM * nN;
        A2 = nullptr; B2 = nullptr; tsA2 = 0; tsB2 = 0; nM2 = 0; nN2 = 0; nwg = nwg1; G = G_; c = c_;
    }
    __device__ void add2(const void* A, size_t tsA, const void* B, size_t tsB, int nM, int nN) {
        A2 = (const char*)A; B2 = (const char*)B; tsA2 = tsA; tsB2 = tsB; nM2 = nM; nN2 = nN; nwg = nwg1 + nM * nN;
    }
    __device__ bool next(int i, Unit& u) const {
        const long L = (long)i * G + c; if (L >= nwg) return false;
        int wgid = (int)L; { const int q = nwg / NXCD, r = nwg % NXCD, xcd = wgid % NXCD, off = wgid / NXCD; wgid = (xcd < r ? xcd * (q + 1) : r * (q + 1) + (xcd - r) * q) + off; }
        if (wgid < nwg1) {
            const int nig = WGM * nN1, gid = wgid / nig, fm = gid * WGM, gsz = (nM1 - fm) < WGM ? (nM1 - fm) : WGM;
            u.pm = fm + ((wgid % nig) % gsz); u.pn = (wgid % nig) / gsz; u.fam = 0;
            u.a = A1 + (size_t)u.pm * tsA1 + (size_t)u.pn * apn; u.b = B1 + (size_t)u.pn * tsB1;
        } else {
            const int w2 = wgid - nwg1; u.pm = w2 % nM2; u.pn = w2 / nM2; u.fam = 1;
            u.a = A2 + (size_t)u.pm * tsA2; u.b = B2 + (size_t)u.pn * tsB2;
        }
        return true;
    }
};

typedef f32x4 Acc[2][2][4][2];

__device__ __forceinline__ void store_plain(const Acc& acc, bf16_t* base, size_t ldc, int row0, int col0, float sc, int wr, int wc, int fr, int fq) {
#pragma unroll
    for (int ai = 0; ai < 2; ++ai)
#pragma unroll
        for (int m = 0; m < 4; ++m) {
            bf16_t* rowp = base + (size_t)(row0 + wr * 64 + fr + ai * HALF + m * 16) * ldc + col0 + wc * 32 + 8 * fq;
#pragma unroll
            for (int bj = 0; bj < 2; ++bj) {
                const f32x4 v0 = acc[ai][bj][m][0] * sc, v1 = acc[ai][bj][m][1] * sc;
                u32x4 w; w.x = cvt_pk_bf16(v0[0], v0[1]); w.y = cvt_pk_bf16(v0[2], v0[3]); w.z = cvt_pk_bf16(v1[0], v1[1]); w.w = cvt_pk_bf16(v1[2], v1[3]);
                *(u32x4*)(rowp + bj * HALF) = w;
            }
        }
}
template <int ACT>
__device__ __forceinline__ void store_pair(const Acc& acc, bf16_t* base, size_t ldc, int row0, int col0, int wr, int wc, int fr, int fq) {
#pragma unroll
    for (int ai = 0; ai < 2; ++ai)
#pragma unroll
        for (int m = 0; m < 4; ++m) {
            bf16_t* rowp = base + (size_t)(row0 + wr * 64 + fr + ai * HALF + m * 16) * ldc + col0 + wc * 32 + 8 * fq;
            float o[8];
#pragma unroll
            for (int n = 0; n < 2; ++n)
#pragma unroll
                for (int e = 0; e < 4; ++e) { const float a = acc[ai][0][m][n][e], b = acc[ai][1][m][n][e]; o[n * 4 + e] = (ACT == 1 ? silu_f(a) : a) * b; }
            u32x4 w; w.x = cvt_pk_bf16(o[0], o[1]); w.y = cvt_pk_bf16(o[2], o[3]); w.z = cvt_pk_bf16(o[4], o[5]); w.w = cvt_pk_bf16(o[6], o[7]);
            *(u32x4*)rowp = w;
        }
}

__device__ __forceinline__ void store_vt(const Acc& acc, bf16_t* base, size_t ldc, int row0, int col0, int wr, int wc, int fr, int fq) {
#pragma unroll
    for (int ai = 0; ai < 2; ++ai)
#pragma unroll
        for (int m = 0; m < 4; ++m) {
            bf16_t* rowp = base + (size_t)(row0 + wr * 64 + fr + ai * HALF + m * 16) * ldc + col0 + wc * 32 + 8 * (fq & ~1) + 4 * (fq & 1);
#pragma unroll
            for (int bj = 0; bj < 2; ++bj) {
                const f32x4 v0 = acc[ai][bj][m][0], v1 = acc[ai][bj][m][1];
                u32x2 w0, w1; w0.x = cvt_pk_bf16(v0[0], v0[1]); w0.y = cvt_pk_bf16(v0[2], v0[3]); w1.x = cvt_pk_bf16(v1[0], v1[1]); w1.y = cvt_pk_bf16(v1[2], v1[3]);
                *(u32x2*)(rowp + bj * HALF) = w0; *(u32x2*)(rowp + bj * HALF + 8) = w1;
            }
        }
}
struct EpiQKV {
    static constexpr bool PERM = true;
    bf16_t *Q, *K, *VT;
    __device__ __forceinline__ void operator()(const Acc& acc, const Unit& u, int wr, int wc, int fr, int fq) const {
        if (u.fam == 0) {
            if (u.pn < 4) store_plain(acc, Q, D, u.pm * BM, u.pn * BM, QSCALE, wr, wc, fr, fq);
            else store_plain(acc, K, D, u.pm * BM, (u.pn - 4) * BM, 1.0f, wr, wc, fr, fq);
        } else store_vt(acc, VT, MTOT, u.pm * BM, u.pn * BM, wr, wc, fr, fq);
    }
};
struct EpiSCin {
    static constexpr bool PERM = true;
    bf16_t *GB, *U;
    __device__ __forceinline__ void operator()(const Acc& acc, const Unit& u, int wr, int wc, int fr, int fq) const {
        if (u.pn < 4) store_plain(acc, GB, D, u.pm * BM, u.pn * BM, 1.0f, wr, wc, fr, fq);
        else store_pair<0>(acc, U, D, u.pm * BM, (u.pn - 4) * HALF, wr, wc, fr, fq);
    }
};
struct EpiSwi {
    static constexpr bool PERM = true;
    bf16_t* Gb;
    __device__ __forceinline__ void operator()(const Acc& acc, const Unit& u, int wr, int wc, int fr, int fq) const {
        store_pair<1>(acc, Gb, FF, u.pm * BM, u.pn * HALF, wr, wc, fr, fq);
    }
};
struct EpiRes {
    static constexpr bool PERM = false;
    const float* res_lat; const float* res_ctx; float* X; const float* gate;   const float* cscale;
    __device__ __forceinline__ void operator()(const Acc& acc, const Unit& u, int wr, int wc, int fr, int fq) const {
        const int row0 = u.pm * BM, colb = u.pn * BM + wc * 32 + 4 * fq;
        const bool lat = row0 < MLAT; const int mb = lat ? (row0 >> 12) : 4;
        const float* gp = gate + (size_t)mb * NMOD;
        const float* rbase = lat ? res_lat : res_ctx - (size_t)MLAT * D;
        f32x4 gv[2][2];
#pragma unroll
        for (int bj = 0; bj < 2; ++bj)
#pragma unroll
            for (int n = 0; n < 2; ++n) { const int c = colb + bj * HALF + n * 16; f32x4 g = *(const f32x4*)(gp + c); if (cscale) g = g * *(const f32x4*)(cscale + c); gv[bj][n] = g; }
#pragma unroll
        for (int ai = 0; ai < 2; ++ai)
#pragma unroll
            for (int m = 0; m < 4; ++m) {
                const size_t off = (size_t)(row0 + wr * 64 + fr + ai * HALF + m * 16) * D;
#pragma unroll
                for (int bj = 0; bj < 2; ++bj)
#pragma unroll
                    for (int n = 0; n < 2; ++n) { const int c = colb + bj * HALF + n * 16; const f32x4 r = *(const f32x4*)(rbase + off + c); *(f32x4*)(X + off + c) = r + gv[bj][n] * acc[ai][bj][m][n]; }
                asm volatile("" ::: "memory");
            }
    }
};

template <class Epi>
__device__ __forceinline__ void gemm_phase(LAS unsigned char* lds, const int K, const int lda, const int ldb, const Sched& S, const Epi& E) {
    const int tid = opaque_tid(), wid = __builtin_amdgcn_readfirstlane(tid >> 6), lane = tid & 63, wr = wid >> 2, wc = wid & 3, fr = lane & 15, fq = lane >> 4;
    const int nt = K / BK;
    unsigned voffA[2], voffB[2];
#pragma unroll
    for (int i = 0; i < 2; ++i) { int R, C; stage_rc(tid * 16 + i * 8192, R, C); const int Rb = Epi::PERM ? ((R & ~31) + perm32(R & 31)) : R;
        voffA[i] = (unsigned)(R * lda + C) * 2u; voffB[i] = (unsigned)(Rb * ldb + C) * 2u; }
    const size_t kstep = (size_t)(BK * 2);
    const size_t hsA = (size_t)HALF * lda * 2, hsB = (size_t)HALF * ldb * 2;
    const unsigned ldsw = (unsigned)wid * 1024u;
    const int aoff = lds_byte(wr * 64 + fr, fq * 8), boff = lds_byte(wc * 32 + fr, fq * 8);
#define PG8_SA(b, h) (((b) * 2 + (h)) * HTB)
#define PG8_SB(b, h) ((4 + (b) * 2 + (h)) * HTB)
#define PG8_STAGE(bufoff, gbase, voff) do { _Pragma("unroll") for (int _i = 0; _i < 2; ++_i) \
        __builtin_amdgcn_global_load_lds((const unsigned*)((const char*)(gbase) + (voff)[_i]), (LAS unsigned*)(lds + (bufoff) + ldsw + _i * 8192), 16, 0, 0); } while (0)
#define PG8_LDA(dst, b, h) do { _Pragma("unroll") for (int m = 0; m < 4; ++m) _Pragma("unroll") for (int k = 0; k < 2; ++k) dst[m][k] = *(const LAS bf16x8*)(lds + PG8_SA(b, h) + aoff + m * 2048 + k * 1024); } while (0)
#define PG8_LDB(dst, b, h) do { _Pragma("unroll") for (int n = 0; n < 2; ++n) _Pragma("unroll") for (int k = 0; k < 2; ++k) dst[n][k] = *(const LAS bf16x8*)(lds + PG8_SB(b, h) + boff + n * 2048 + k * 1024); } while (0)
#define PG8_MMA(ai, bj, At, Bt) do { __builtin_amdgcn_s_setprio(1); _Pragma("unroll") for (int m = 0; m < 4; ++m) _Pragma("unroll") for (int n = 0; n < 2; ++n) _Pragma("unroll") for (int k = 0; k < 2; ++k) \
        acc[ai][bj][m][n] = __builtin_amdgcn_mfma_f32_16x16x32_bf16(Bt[n][k], At[m][k], acc[ai][bj][m][n], 0, 0, 0); __builtin_amdgcn_s_setprio(0); } while (0)
#define PG8_WAIT_V(n) asm volatile("s_waitcnt vmcnt(" #n ")" ::: "memory")
#define PG8_WAIT_L(n) asm volatile("s_waitcnt lgkmcnt(" #n ")" ::: "memory")
#define PG8_BAR __builtin_amdgcn_s_barrier()
#define PG8_SCHED __builtin_amdgcn_sched_barrier(0)
    Unit cur, nxt; int ui = 0;
    if (!S.next(0, cur)) return;
    Acc acc;
#pragma unroll
    for (int a = 0; a < 2; ++a)
#pragma unroll
        for (int b = 0; b < 2; ++b)
#pragma unroll
            for (int m = 0; m < 4; ++m)
#pragma unroll
                for (int n = 0; n < 2; ++n) acc[a][b][m][n] = (f32x4){0.f, 0.f, 0.f, 0.f};
    bf16x8 At[4][2], B0[2][2], B1[2][2];
    const char* cA = cur.a; const char* cB = cur.b;
    PG8_STAGE(PG8_SB(0, 0), cB, voffB); PG8_STAGE(PG8_SB(0, 1), cB + hsB, voffB); PG8_STAGE(PG8_SA(0, 0), cA, voffA); PG8_STAGE(PG8_SA(0, 1), cA + hsA, voffA);
    if (wr == 1) PG8_BAR;
    PG8_WAIT_V(2); PG8_BAR;
    PG8_STAGE(PG8_SB(1, 0), cB + kstep, voffB); PG8_STAGE(PG8_SA(1, 0), cA + kstep, voffA); PG8_STAGE(PG8_SB(1, 1), cB + hsB + kstep, voffB);
    PG8_WAIT_V(6); PG8_BAR;
    for (;;) {
        const bool has_next = S.next(ui + 1, nxt);
        const char* nA = has_next ? nxt.a : cA; const char* nB = has_next ? nxt.b : cB;
        for (int t = 0; t < nt; t += 2) {
            const bool last = (t == nt - 2);
            const char* a1 = cA + (size_t)(t + 1) * kstep;
            const char* a2 = last ? nA : cA + (size_t)(t + 2) * kstep; const char* b2 = last ? nB : cB + (size_t)(t + 2) * kstep;
            const char* a3 = a2 + kstep; const char* b3 = b2 + kstep;
            PG8_LDB(B0, 0, 0); PG8_LDB(B1, 0, 1); PG8_SCHED; PG8_LDA(At, 0, 0); PG8_STAGE(PG8_SA(1, 1), a1 + hsA, voffA);
            PG8_WAIT_V(8); PG8_WAIT_L(0); PG8_BAR; PG8_MMA(0, 0, At, B0); PG8_MMA(0, 1, At, B1); PG8_BAR; PG8_SCHED;
            PG8_LDA(At, 0, 1); PG8_STAGE(PG8_SB(0, 0), b2, voffB); PG8_STAGE(PG8_SB(0, 1), b2 + hsB, voffB); PG8_STAGE(PG8_SA(0, 0), a2, voffA);
            PG8_WAIT_V(8); PG8_WAIT_L(0); PG8_BAR; PG8_MMA(1, 0, At, B0); PG8_MMA(1, 1, At, B1); PG8_BAR; PG8_SCHED;
            PG8_LDB(B0, 1, 0); PG8_LDB(B1, 1, 1); PG8_SCHED; PG8_LDA(At, 1, 0); PG8_STAGE(PG8_SA(0, 1), a2 + hsA, voffA);
            PG8_WAIT_V(8); PG8_WAIT_L(0); PG8_BAR; PG8_MMA(0, 0, At, B0); PG8_MMA(0, 1, At, B1); PG8_BAR; PG8_SCHED;
            PG8_LDA(At, 1, 1); PG8_STAGE(PG8_SB(1, 0), b3, voffB); PG8_STAGE(PG8_SB(1, 1), b3 + hsB, voffB); PG8_STAGE(PG8_SA(1, 0), a3, voffA);
            PG8_WAIT_V(8); PG8_WAIT_L(0); PG8_BAR; PG8_MMA(1, 0, At, B0); PG8_MMA(1, 1, At, B1); PG8_BAR; PG8_SCHED;
        }
        if (wr == 0) PG8_BAR;
        E(acc, cur, wr, wc, fr, fq);
        if (!has_next) break;
#pragma unroll
        for (int a = 0; a < 2; ++a)
#pragma unroll
            for (int b = 0; b < 2; ++b)
#pragma unroll
                for (int m = 0; m < 4; ++m)
#pragma unroll
                    for (int n = 0; n < 2; ++n) acc[a][b][m][n] = (f32x4){0.f, 0.f, 0.f, 0.f};
        cur = nxt; cA = nA; cB = nB; ++ui;
        if (wr == 1) PG8_BAR;
    }
    PG8_WAIT_V(0);
    PG8_BAR;
#undef PG8_SA
#undef PG8_SB
#undef PG8_STAGE
#undef PG8_LDA
#undef PG8_LDB
#undef PG8_MMA
#undef PG8_WAIT_V
#undef PG8_WAIT_L
#undef PG8_BAR
#undef PG8_SCHED
}
}


#define XB_TMO      128
#define XB_XCNT(j)  (256  + 64 * (j))
#define XB_XSUB(j)  (1280 + 64 * (j))
#define XB_XGEN(j)  (2304 + 64 * (j))
#define XB_TOP      3328
#define XB_TOPGEN   3392
#define XCD_BAR_WORDS 3456
#define XB_SPIN_CAP (1u << 18)
__device__ __forceinline__ unsigned xb_ld(unsigned* p)              { return __hip_atomic_load(p, __ATOMIC_RELAXED, __HIP_MEMORY_SCOPE_AGENT); }
__device__ __forceinline__ unsigned xb_add(unsigned* p, unsigned v) { return __hip_atomic_fetch_add(p, v, __ATOMIC_RELAXED, __HIP_MEMORY_SCOPE_AGENT); }
__device__ __forceinline__ unsigned xb_xcc_id() { return (unsigned)__builtin_amdgcn_s_getreg((3 << 11) | 20) & 0xFu; }
#define XB_SPIN(cond, bar) do { unsigned _sp = 0; while (cond) { __builtin_amdgcn_s_sleep(1); \
    if ((++_sp & 255u) == 0u) { if (xb_ld(&(bar)[XB_TMO])) break; if (_sp > XB_SPIN_CAP) { atomicAdd(&(bar)[XB_TMO], 1u); break; } } } } while (0)
struct XcdBarrier { unsigned* bar; unsigned x; volatile LAS unsigned* st; };
__device__ __forceinline__ XcdBarrier xcd_barrier_post(unsigned* bar, volatile LAS unsigned* st) {
    XcdBarrier b; b.bar = bar; b.x = xb_xcc_id(); b.st = st;
    if (threadIdx.x == 0) (void)xb_add(&bar[XB_XCNT(b.x)], 1u);
    return b;
}
__device__ __forceinline__ void xcd_barrier_complete(unsigned* bar, unsigned x, unsigned& nloc, unsigned& nx) {
    const unsigned G = gridDim.x * gridDim.y * gridDim.z;
    unsigned sum, cnt, mine, sp = 0u;
    for (;;) {
        sum = 0u; cnt = 0u; mine = 0u;
#pragma unroll
        for (unsigned j = 0; j < 16; ++j) { const unsigned c = xb_ld(&bar[XB_XCNT(j)]); sum += c; cnt += (c > 0u) ? 1u : 0u; mine = (j == x) ? c : mine; }
        if (sum == G) break;
        __builtin_amdgcn_s_sleep(1);
        if ((++sp & 255u) == 0u) { if (xb_ld(&bar[XB_TMO])) break; if (sp > XB_SPIN_CAP) { atomicAdd(&bar[XB_TMO], 1u); break; } }
    }
    nloc = mine > 0u ? mine : 1u; nx = cnt > 0u ? cnt : 1u;
}
__device__ __forceinline__ void xcd_barrier(const XcdBarrier& b) {
    asm volatile("s_waitcnt vmcnt(0)" ::: "memory");
    __syncthreads();
    if (threadIdx.x == 0) {
        unsigned* bar = b.bar;
        __builtin_amdgcn_s_waitcnt(0);
        unsigned nloc = b.st[0], nx = b.st[1];
        if (nloc == 0u) { xcd_barrier_complete(bar, b.x, nloc, nx); b.st[0] = nloc; b.st[1] = nx; }
        const unsigned old = xb_add(&bar[XB_XSUB(b.x)], 1u);
        const unsigned gen = old / nloc;
        if (old + 1u == (gen + 1u) * nloc) {
            __builtin_amdgcn_fence(__ATOMIC_RELEASE, "agent");
            asm volatile("s_waitcnt vmcnt(0)" ::: "memory");
            const unsigned og = xb_add(&bar[XB_TOP], 1u);
            const unsigned tg = og / nx;
            if (og + 1u == (tg + 1u) * nx) xb_add(&bar[XB_TOPGEN], 1u);
            else XB_SPIN(xb_ld(&bar[XB_TOPGEN]) == tg, bar);
            __builtin_amdgcn_fence(__ATOMIC_ACQUIRE, "agent");
            xb_add(&bar[XB_XGEN(b.x)], 1u);
            asm volatile("s_waitcnt vmcnt(0)" ::: "memory");
        } else {
            XB_SPIN(xb_ld(&bar[XB_XGEN(b.x)]) == gen, bar);
            __builtin_amdgcn_fence(__ATOMIC_ACQUIRE, "agent");
            asm volatile("s_waitcnt vmcnt(0)" ::: "memory");
        }
    }
    __syncthreads();
}

struct Args {
    const float *x, *c, *ctx, *c_ctx, *adaln_w, *adaln_b, *norm_mix_g, *norm_ffn_g, *ffn_w1, *ffn_w3, *ffn_w2;
    const float *na_w_qkv, *na_w_o, *na_rpb, *sc_w_in, *sc_conv_w, *sc_w_out, *pool_w, *pool_scale, *final_g;
    float* out; unsigned char* ws;
};

__device__ __forceinline__ void transpose_item(const float* W, int N, int k0, int n0, bf16_t* WT, int ldk, int row_base, LAS float* scr, int lane) {
#pragma unroll 8
    for (int i = 0; i < 32; ++i) { const int kk = 2 * i + (lane >> 5); scr[kk * 33 + (lane & 31)] = W[(size_t)(k0 + kk) * N + n0 + (lane & 31)]; }
    asm volatile("s_waitcnt lgkmcnt(0)" ::: "memory");
    const int c = lane & 7;
#pragma unroll
    for (int j = 0; j < 4; ++j) { const int n = (lane >> 3) + 8 * j; const LAS float* s = scr + (8 * c) * 33 + n;
        u32x4 o; o.x = cvt_pk_bf16(s[0 * 33], s[1 * 33]); o.y = cvt_pk_bf16(s[2 * 33], s[3 * 33]); o.z = cvt_pk_bf16(s[4 * 33], s[5 * 33]); o.w = cvt_pk_bf16(s[6 * 33], s[7 * 33]);
        *(u32x4*)(WT + (size_t)(row_base + n) * ldk + k0 + 8 * c) = o; }
    asm volatile("s_waitcnt lgkmcnt(0)" ::: "memory");
}

__device__ __forceinline__ void prologue_phase(const Args& P, LAS unsigned char* lds) {
    const int tid = opaque_tid(), lane = tid & 63, wave = __builtin_amdgcn_readfirstlane(tid >> 6);
    unsigned char* ws = P.ws;
    LAS float* S = (LAS float*)lds;
    LAS float* red = (LAS float*)(lds + 5 * 1024 * 4);
    for (int i = tid; i < 5 * D; i += NTHREADS) { const float v = i < 4 * D ? P.c[i] : P.c_ctx[i - 4 * D]; S[i] = v / (1.0f + __expf(-v)); }
    __syncthreads();
    float* mods = (float*)(ws + WS_MODS);
    for (int item = blockIdx.x; item < NLAYER * (NMOD / 32); item += gridDim.x) {
        const int layer = item / (NMOD / 32), c0 = (item % (NMOD / 32)) * 32;
        const int kk = lane >> 3, cgp = lane & 7;
        const float* W = P.adaln_w + (size_t)layer * D * NMOD + c0 + 4 * cgp;
        f32x4 acc[5];
#pragma unroll
        for (int b = 0; b < 5; ++b) acc[b] = (f32x4){0.f, 0.f, 0.f, 0.f};
#pragma unroll 4
        for (int i = 0; i < 16; ++i) {
            const int k = 128 * wave + 8 * i + kk;
            const f32x4 wv = *(const f32x4*)(W + (size_t)k * NMOD);
#pragma unroll
            for (int b = 0; b < 5; ++b) acc[b] += wv * S[b * D + k];
        }
#pragma unroll
        for (int b = 0; b < 5; ++b)
#pragma unroll
            for (int e = 0; e < 4; ++e) { float v = acc[b][e]; v += __shfl_xor(v, 8); v += __shfl_xor(v, 16); v += __shfl_xor(v, 32); acc[b][e] = v; }
        if (lane < 8) {
#pragma unroll
            for (int b = 0; b < 5; ++b)
#pragma unroll
                for (int e = 0; e < 4; ++e) red[(wave * 5 + b) * 32 + 4 * cgp + e] = acc[b][e];
        }
        __syncthreads();
        if (tid < 160) { const int b = tid >> 5, cc = tid & 31; float s = P.adaln_b[(size_t)layer * NMOD + c0 + cc];
#pragma unroll
            for (int w = 0; w < 8; ++w) s += red[(w * 5 + b) * 32 + cc];
            mods[((size_t)layer * 5 + b) * NMOD + c0 + cc] = s; }
        __syncthreads();
    }
    LAS float* scr = (LAS float*)(lds + wave * 16384);
    const int gw = blockIdx.x * NWAVES + wave, NGW = gridDim.x * NWAVES;
    constexpr int I_QKV = 16 * 96, I_WO = 16 * 32, I_POOL = 4 * 8, I_W1 = 16 * 88, I_W2 = 44 * 32;
    constexpr int T_QKV = 2 * I_QKV, T_WO = 2 * I_WO, T_SCIN = I_QKV, T_SCOUT = I_WO, T_POOL = 4 * I_POOL, T_W1 = 4 * I_W1, T_W3 = 4 * I_W1, T_W2 = 4 * I_W2;
    constexpr int NITEMS = T_QKV + T_WO + T_SCIN + T_SCOUT + T_POOL + T_W1 + T_W3 + T_W2;
    for (int it = gw; it < NITEMS; it += NGW) {
        int r = it;
        if (r < T_QKV) { const int l = r / I_QKV, q = r % I_QKV, kb = q / 96, nb = q % 96;
            transpose_item(P.na_w_qkv + (size_t)l * D * 3 * D, 3 * D, 64 * kb, 32 * nb, (bf16_t*)(ws + WS_WQKV) + (size_t)l * 3 * D * D, D, 32 * nb, scr, lane); continue; } r -= T_QKV;
        if (r < T_WO) { const int l = r / I_WO, q = r % I_WO, kb = q / 32, nb = q % 32;
            transpose_item(P.na_w_o + (size_t)l * D * D, D, 64 * kb, 32 * nb, (bf16_t*)(ws + WS_WO) + (size_t)l * D * D, D, 32 * nb, scr, lane); continue; } r -= T_WO;
        if (r < T_SCIN) { const int kb = r / 96, nb = r % 96, n0 = 32 * nb;
            int rb; if (n0 < D) rb = n0; else if (n0 < 2 * D) { const int j = n0 - D; rb = D + (j / 128) * 256 + (j % 128); } else { const int j = n0 - 2 * D; rb = D + (j / 128) * 256 + 128 + (j % 128); }
            transpose_item(P.sc_w_in, 3 * D, 64 * kb, n0, (bf16_t*)(ws + WS_WSCIN), D, rb, scr, lane); continue; } r -= T_SCIN;
        if (r < T_SCOUT) { const int kb = r / 32, nb = r % 32;
            transpose_item(P.sc_w_out, D, 64 * kb, 32 * nb, (bf16_t*)(ws + WS_WSCOUT), D, 32 * nb, scr, lane); continue; } r -= T_SCOUT;
        if (r < T_POOL) { const int g = r / I_POOL, q = r % I_POOL, kb = q / 8, nb = q % 8;
            transpose_item(P.pool_w + (size_t)g * 256 * 256, 256, 64 * kb, 32 * nb, (bf16_t*)(ws + WS_WPOOL) + (size_t)g * 256 * 256, 256, 32 * nb, scr, lane); continue; } r -= T_POOL;
        if (r < T_W1 + T_W3) { const int which = r / T_W1; r -= which * T_W1; const int l = r / I_W1, q = r % I_W1, kb = q / 88, nb = q % 88, n0 = 32 * nb;
            const float* src = (which ? P.ffn_w3 : P.ffn_w1) + (size_t)l * D * FF;
            transpose_item(src, FF, 64 * kb, n0, (bf16_t*)(ws + WS_W13) + (size_t)l * 2 * FF * D, D, (n0 / 128) * 256 + which * 128 + (n0 % 128), scr, lane); continue; } r -= T_W1 + T_W3;
        { const int l = r / I_W2, q = r % I_W2, kb = q / 32, nb = q % 32;
            transpose_item(P.ffn_w2 + (size_t)l * FF * D, D, 64 * kb, 32 * nb, (bf16_t*)(ws + WS_W2) + (size_t)l * D * FF, FF, 32 * nb, scr, lane); }
    }
}

__device__ __forceinline__ void norm_phase(const float* src_lat, const float* src_ctx, const float* g, const float* mods_l, int shift_i, int scale_i, bf16_t* H, int nrows) {
    const int tid = opaque_tid(), lane = tid & 63, wave = __builtin_amdgcn_readfirstlane(tid >> 6);
    const int gw = blockIdx.x * NWAVES + wave, NGW = gridDim.x * NWAVES;
    for (int m = gw; m < nrows; m += NGW) {
        const float* xr = m < MLAT ? src_lat + (size_t)m * D : src_ctx + (size_t)(m - MLAT) * D;
        const int mb = m < MLAT ? (m >> 12) : 4;
        const float* sh = mods_l + (size_t)mb * NMOD + shift_i * D; const float* sc = mods_l + (size_t)mb * NMOD + scale_i * D;
        f32x4 v[4]; float s = 0.f;
#pragma unroll
        for (int j = 0; j < 4; ++j) { v[j] = *(const f32x4*)(xr + 4 * lane + 256 * j); s += (v[j][0] * v[j][0] + v[j][1] * v[j][1]) + (v[j][2] * v[j][2] + v[j][3] * v[j][3]); }
        const float rstd = 1.0f / sqrtf(wave_sum(s) * (1.0f / D) + EPS);
#pragma unroll
        for (int j = 0; j < 4; ++j) { const int c = 4 * lane + 256 * j;
            const f32x4 gv = *(const f32x4*)(g + c), scv = *(const f32x4*)(sc + c), shv = *(const f32x4*)(sh + c);
            const f32x4 o = (v[j] * rstd) * gv * (scv + 1.0f) + shv;
            u32x2 w; w.x = cvt_pk_bf16(o[0], o[1]); w.y = cvt_pk_bf16(o[2], o[3]);
            *(u32x2*)(H + (size_t)m * D + c) = w; }
    }
}
__device__ __forceinline__ void final_norm_phase(const float* X, const float* g, float* out) {
    const int tid = opaque_tid(), lane = tid & 63, wave = __builtin_amdgcn_readfirstlane(tid >> 6);
    const int gw = blockIdx.x * NWAVES + wave, NGW = gridDim.x * NWAVES;
    for (int m = gw; m < MLAT; m += NGW) {
        const float* xr = X + (size_t)m * D;
        f32x4 v[4]; float s = 0.f;
#pragma unroll
        for (int j = 0; j < 4; ++j) { v[j] = *(const f32x4*)(xr + 4 * lane + 256 * j); s += (v[j][0] * v[j][0] + v[j][1] * v[j][1]) + (v[j][2] * v[j][2] + v[j][3] * v[j][3]); }
        const float rstd = 1.0f / sqrtf(wave_sum(s) * (1.0f / D) + EPS);
#pragma unroll
        for (int j = 0; j < 4; ++j) { const int c = 4 * lane + 256 * j; *(f32x4*)(out + (size_t)m * D + c) = (v[j] * rstd) * *(const f32x4*)(g + c); }
    }
}

__device__ __forceinline__ void pool_phase(const float* X, const float* g, const float* mods_l, bf16_t* Pq, LAS float* rs) {
    const int tid = opaque_tid(), lane = tid & 63, wave = __builtin_amdgcn_readfirstlane(tid >> 6);
    for (int ch = blockIdx.x; ch < MTOT / 16; ch += gridDim.x) {
        const int m0 = ch * 16; int s0, s1, mb;
        if (m0 < MLAT) { s0 = m0 & ~4095; s1 = s0 + 4096; mb = m0 >> 12; } else { s0 = MLAT + ((m0 - MLAT) & ~255); s1 = s0 + 256; mb = 4; }
        const int lo = max(m0 - 8, s0), hi = min(m0 + 24, s1);
        for (int r = lo + wave; r < hi; r += NWAVES) {
            const float* xr = X + (size_t)r * D; float s = 0.f;
#pragma unroll
            for (int j = 0; j < 4; ++j) { const f32x4 v = *(const f32x4*)(xr + 4 * lane + 256 * j); s += (v[0] * v[0] + v[1] * v[1]) + (v[2] * v[2] + v[3] * v[3]); }
            const float rstd = 1.0f / sqrtf(wave_sum(s) * (1.0f / D) + EPS);
            if (lane == 0) rs[r - lo] = rstd;
        }
        __syncthreads();
        const int c = 2 * tid, hw = 1 << (c >> 8);
        const f32x2 gv = *(const f32x2*)(g + c), scv = *(const f32x2*)(mods_l + (size_t)mb * NMOD + 1 * D + c);
        const f32x2 Gv = gv * (scv + 1.0f);
        int wl = max(m0 - hw, s0), wh = min(m0 + hw, s1);
        f32x2 sum = (f32x2){0.f, 0.f};
        for (int r = wl; r < wh; ++r) sum += *(const f32x2*)(X + (size_t)r * D + c) * rs[r - lo];
        for (int t = m0; t < m0 + 16; ++t) {
            if (t > m0) {
                const int nl = max(t - hw, s0), nh = min(t + hw, s1);
                if (nh > wh) { sum += *(const f32x2*)(X + (size_t)wh * D + c) * rs[wh - lo]; wh = nh; }
                if (nl > wl) { sum -= *(const f32x2*)(X + (size_t)wl * D + c) * rs[wl - lo]; wl = nl; }
            }
            const float inv = 1.0f / (float)(wh - wl);
            const f32x2 xc = *(const f32x2*)(X + (size_t)t * D + c) * rs[t - lo];
            const f32x2 p = (sum * inv - xc) * Gv;
            *(unsigned*)(Pq + (size_t)t * D + c) = cvt_pk_bf16(p[0], p[1]);
        }
        __syncthreads();
    }
}

__device__ __forceinline__ void conv_phase(const bf16_t* GB, const bf16_t* U, const float* cw, bf16_t* Z) {
    const int tid = opaque_tid();
    const long total = (long)MTOT * 128, nth = (long)gridDim.x * NTHREADS;
    for (long idx = (long)blockIdx.x * NTHREADS + tid; idx < total; idx += nth) {
        const int m = (int)(idx >> 7), c8 = (int)(idx & 127) * 8;
        const int pos = m < MLAT ? (m & 4095) : ((m - MLAT) & 255), len = m < MLAT ? 4096 : 256;
        const u32x4 zero = (u32x4){0u, 0u, 0u, 0u};
        const u32x4 g4 = *(const u32x4*)(GB + (size_t)m * D + c8), u0 = *(const u32x4*)(U + (size_t)m * D + c8);
        const u32x4 um = pos > 0 ? *(const u32x4*)(U + (size_t)(m - 1) * D + c8) : zero;
        const u32x4 up = pos < len - 1 ? *(const u32x4*)(U + (size_t)(m + 1) * D + c8) : zero;
        float o[8];
#pragma unroll
        for (int e = 0; e < 4; ++e) {
            const int c = c8 + 2 * e;
            const f32x2 w0 = *(const f32x2*)(cw + c), w1 = *(const f32x2*)(cw + D + c), w2 = *(const f32x2*)(cw + 2 * D + c);
            o[2 * e] = bf_lo(g4[e]) * (bf_lo(um[e]) * w0[0] + bf_lo(u0[e]) * w1[0] + bf_lo(up[e]) * w2[0]);
            o[2 * e + 1] = bf_hi(g4[e]) * (bf_hi(um[e]) * w0[1] + bf_hi(u0[e]) * w1[1] + bf_hi(up[e]) * w2[1]);
        }
        u32x4 w; w.x = cvt_pk_bf16(o[0], o[1]); w.y = cvt_pk_bf16(o[2], o[3]); w.z = cvt_pk_bf16(o[4], o[5]); w.w = cvt_pk_bf16(o[6], o[7]);
        *(u32x4*)(Z + (size_t)m * D + c8) = w;
    }
}

__device__ __forceinline__ void attn_naive_phase(const bf16_t* Q, const bf16_t* Kb, const bf16_t* VT, bf16_t* O, const float* rpb, LAS float* pl_all, int nrows) {
    const int tid = opaque_tid(), lane = tid & 63, wave = __builtin_amdgcn_readfirstlane(tid >> 6);
    const int gw = blockIdx.x * NWAVES + wave, NGW = gridDim.x * NWAVES;
    LAS float* pl = pl_all + wave * 384;
    for (long task = gw; task < (long)nrows * NH; task += NGW) {
        const int m = (int)(task >> 4), h = (int)(task & 15);
        const bool lat = m < MLAT; const int b = lat ? (m >> 12) : ((m - MLAT) >> 8);
        int r = 0, qc = 0, start = 0, cs = 0;
        if (lat) { const int t = m & 4095; r = t >> 6; qc = t & 63; start = min(max(r - 4, 0), 56); cs = min(max(qc - 8, 0), 48); }
        const int ctxbase = MLAT + b * 256;
        u32x4 qv[8];
#pragma unroll
        for (int i = 0; i < 8; ++i) qv[i] = *(const u32x4*)(Q + (size_t)m * D + h * 64 + 8 * i);
        float s[6];
#pragma unroll
        for (int i = 0; i < 6; ++i) {
            int tok = 0; float bias = 0.f; bool valid = true;
            if (i < 2) {
                if (!lat) valid = false;
                else { const int j = lane + 64 * i, kr = start + (j >> 4), kc = cs + (j & 15); tok = b * 4096 + kr * 64 + kc;
                    bias = rpb[(h * 15 + (kr - r + 7)) * 31 + (kc - qc + 15)] * LOG2E; }
            } else tok = ctxbase + lane + 64 * (i - 2);
            float dot = 0.f;
            if (valid) {
                const bf16_t* kp = Kb + (size_t)tok * D + h * 64;
#pragma unroll
                for (int ii = 0; ii < 8; ++ii) { const u32x4 kv = *(const u32x4*)(kp + 8 * ii);
#pragma unroll
                    for (int e = 0; e < 4; ++e) dot += bf_lo(qv[ii][e]) * bf_lo(kv[e]) + bf_hi(qv[ii][e]) * bf_hi(kv[e]); }
                s[i] = dot + bias;
            } else s[i] = -INFINITY;
        }
        float mx = s[0];
#pragma unroll
        for (int i = 1; i < 6; ++i) mx = fmaxf(mx, s[i]);
        mx = wave_max(mx);
        float sum = 0.f;
#pragma unroll
        for (int i = 0; i < 6; ++i) { const float p = exp2f(s[i] - mx); sum += p; pl[lane + 64 * i] = p; }
        sum = wave_sum(sum);
        __builtin_amdgcn_wave_barrier();
        asm volatile("s_waitcnt lgkmcnt(0)" ::: "memory");
        const bf16_t* vrow = VT + (size_t)(h * 64 + lane) * MTOT;
        float o = 0.f;
        if (lat) {
            for (int j = 0; j < 128; ++j) { const int tok = b * 4096 + (start + (j >> 4)) * 64 + cs + (j & 15); o += pl[j] * bf2f(vrow[tok]); }
        }
        for (int l8 = 0; l8 < 32; ++l8) {
            const u32x4 vv = *(const u32x4*)(vrow + ctxbase + 8 * l8);
#pragma unroll
            for (int e = 0; e < 4; ++e) o += pl[128 + 8 * l8 + 2 * e] * bf_lo(vv[e]) + pl[128 + 8 * l8 + 2 * e + 1] * bf_hi(vv[e]);
        }
        const float res = o / sum;
        O[(size_t)m * D + h * 64 + lane] = (bf16_t)(cvt_pk_bf16(res, 0.f) & 0xffffu);
        __builtin_amdgcn_wave_barrier();
        asm volatile("s_waitcnt lgkmcnt(0)" ::: "memory");
    }
}


typedef float f32x16 __attribute__((ext_vector_type(16)));
constexpr int RPB_PAD = 64, RPB_N = NH * 15 * 31;
template <bool BAND>
__device__ __forceinline__ void attn_tile(const bf16_t* Kt, const bf16_t* Vt, const bf16x8 (&qr)[4], float& mref, float& l, f32x16& o0, f32x16& o1,
                                          const LAS float* brow, int lo, int r32, int hi) {
    bf16x8 kf[2][4];
#pragma unroll
    for (int p = 0; p < 2; ++p)
#pragma unroll
        for (int d0 = 0; d0 < 4; ++d0) kf[p][d0] = *(const bf16x8*)(Kt + (size_t)(r32 + 32 * p) * D + 16 * d0 + 8 * hi);
    u32x2 va[2][4], vb[2][4];
#pragma unroll
    for (int dh = 0; dh < 2; ++dh)
#pragma unroll
        for (int sl = 0; sl < 4; ++sl) { const bf16_t* vp = Vt + (size_t)(r32 + 32 * dh) * MTOT + 16 * sl + 4 * hi; va[dh][sl] = *(const u32x2*)vp; vb[dh][sl] = *(const u32x2*)(vp + 8); }
    f32x16 p0, p1;
#pragma unroll
    for (int r = 0; r < 16; ++r) { p0[r] = 0.f; p1[r] = 0.f; }
#pragma unroll
    for (int d0 = 0; d0 < 4; ++d0) { p0 = __builtin_amdgcn_mfma_f32_32x32x16_bf16(kf[0][d0], qr[d0], p0, 0, 0, 0); p1 = __builtin_amdgcn_mfma_f32_32x32x16_bf16(kf[1][d0], qr[d0], p1, 0, 0, 0); }
    if (BAND) {
#pragma unroll
        for (int r = 0; r < 16; ++r) { const int C0 = (r & 3) + 8 * (r >> 2);
            p0[r] = ((unsigned)(C0 - lo) < 16u) ? p0[r] + brow[C0] : -INFINITY;
            p1[r] = ((unsigned)(C0 + 32 - lo) < 16u) ? p1[r] + brow[C0 + 32] : -INFINITY; }
    }
    float mt = fmaxf(p0[0], p1[0]);
#pragma unroll
    for (int r = 1; r < 16; ++r) mt = fmaxf(mt, fmaxf(p0[r], p1[r]));
    mt = fmaxf(mt, __shfl_xor(mt, 32));
    if (__any(mt > mref + 8.0f)) {
        const float mnew = (mt > mref + 8.0f) ? mt : mref;
        const float alpha = __builtin_amdgcn_exp2f(mref - mnew);
        l *= alpha;
#pragma unroll
        for (int r = 0; r < 16; ++r) { o0[r] *= alpha; o1[r] *= alpha; }
        mref = mnew;
    }
    float ls = 0.f;
#pragma unroll
    for (int r = 0; r < 16; ++r) { p0[r] = __builtin_amdgcn_exp2f(p0[r] - mref); p1[r] = __builtin_amdgcn_exp2f(p1[r] - mref); ls += p0[r] + p1[r]; }
    l += ls;
    bf16x8 pf[4];
#pragma unroll
    for (int sl = 0; sl < 4; ++sl) {
        u32x4 w;
        if (sl < 2) { const int o = 8 * sl; w.x = cvt_pk_bf16(p0[o], p0[o + 1]); w.y = cvt_pk_bf16(p0[o + 2], p0[o + 3]); w.z = cvt_pk_bf16(p0[o + 4], p0[o + 5]); w.w = cvt_pk_bf16(p0[o + 6], p0[o + 7]); }
        else { const int o = 8 * (sl - 2); w.x = cvt_pk_bf16(p1[o], p1[o + 1]); w.y = cvt_pk_bf16(p1[o + 2], p1[o + 3]); w.z = cvt_pk_bf16(p1[o + 4], p1[o + 5]); w.w = cvt_pk_bf16(p1[o + 6], p1[o + 7]); }
        pf[sl] = __builtin_bit_cast(bf16x8, w);
    }
#pragma unroll
    for (int sl = 0; sl < 4; ++sl) {
        const u32x4 a0 = (u32x4){va[0][sl].x, va[0][sl].y, vb[0][sl].x, vb[0][sl].y}, a1 = (u32x4){va[1][sl].x, va[1][sl].y, vb[1][sl].x, vb[1][sl].y};
        o0 = __builtin_amdgcn_mfma_f32_32x32x16_bf16(__builtin_bit_cast(bf16x8, a0), pf[sl], o0, 0, 0, 0);
        o1 = __builtin_amdgcn_mfma_f32_32x32x16_bf16(__builtin_bit_cast(bf16x8, a1), pf[sl], o1, 0, 0, 0);
    }
}
__device__ __forceinline__ void attn_unit(const bf16_t* Q, const bf16_t* Kb, const bf16_t* VT, bf16_t* O, const LAS float* tab, int b, int h, int m0, bool lat, int r, int qc0, int lane) {
    const int r32 = lane & 31, hi = lane >> 5;
    bf16x8 qr[4];
#pragma unroll
    for (int d0 = 0; d0 < 4; ++d0) qr[d0] = *(const bf16x8*)(Q + (size_t)(m0 + r32) * D + h * 64 + 16 * d0 + 8 * hi);
    float mref = -INFINITY, l = 0.f; f32x16 o0, o1;
#pragma unroll
    for (int i = 0; i < 16; ++i) { o0[i] = 0.f; o1[i] = 0.f; }
    const bf16_t* Vh = VT + (size_t)(h * 64) * MTOT;
    const int ctxbase = MLAT + b * 256;
    for (int ti = 0; ti < 4; ++ti) {
        const int tok0 = ctxbase + 64 * ti;
        attn_tile<false>(Kb + (size_t)tok0 * D + h * 64, Vh + tok0, qr, mref, l, o0, o1, tab, 0, r32, hi);
    }
    if (lat) {
        const int qc = qc0 + r32, cs = min(max(qc - 8, 0), 48), start = min(max(r - 4, 0), 56);
        const int lo = cs - 4 * hi;
        const LAS float* lb = tab + RPB_PAD + h * 15 * 31 + (4 * hi - qc + 15);
        for (int ti = 0; ti < 8; ++ti) {
            const int kr = start + ti, tok0 = b * 4096 + kr * 64;
            attn_tile<true>(Kb + (size_t)tok0 * D + h * 64, Vh + tok0, qr, mref, l, o0, o1, lb + (kr - r + 7) * 31, lo, r32, hi);
        }
    }
    l += __shfl_xor(l, 32);
    const float inv = 1.0f / l;
    bf16_t* op = O + (size_t)(m0 + r32) * D + h * 64 + 4 * hi;
#pragma unroll
    for (int g = 0; g < 4; ++g) {
        u32x2 w0, w1;
        w0.x = cvt_pk_bf16(o0[4 * g] * inv, o0[4 * g + 1] * inv); w0.y = cvt_pk_bf16(o0[4 * g + 2] * inv, o0[4 * g + 3] * inv);
        w1.x = cvt_pk_bf16(o1[4 * g] * inv, o1[4 * g + 1] * inv); w1.y = cvt_pk_bf16(o1[4 * g + 2] * inv, o1[4 * g + 3] * inv);
        *(u32x2*)(op + 8 * g) = w0; *(u32x2*)(op + 32 + 8 * g) = w1;
    }
}
__device__ __forceinline__ void attn_phase(const bf16_t* Q, const bf16_t* Kb, const bf16_t* VT, bf16_t* O, const float* rpb, LAS float* tab, int nrows) {
    const int tid = opaque_tid(), lane = tid & 63, wave = __builtin_amdgcn_readfirstlane(tid >> 6);
    for (int i = tid; i < RPB_N + 2 * RPB_PAD; i += NTHREADS) { const int k = i - RPB_PAD; tab[i] = (k >= 0 && k < RPB_N) ? rpb[k] * LOG2E : 0.f; }
    __syncthreads();
    for (int wi = blockIdx.x; wi < 256; wi += gridDim.x) {
        const int bh = wi >> 2, rg = wi & 3, b = bh >> 4, h = bh & 15;
        for (int u = 0; u < 4; ++u) {
            const int r = rg * 16 + 2 * wave + (u >> 1), half = u & 1;
            attn_unit(Q, Kb, VT, O, tab, b, h, b * 4096 + r * 64 + 32 * half, true, r, 32 * half, lane);
        }
    }
    if (nrows == MTOT) {
        const int gw = blockIdx.x * NWAVES + wave, NGW = gridDim.x * NWAVES;
        for (int cu = gw; cu < 2048; cu += NGW) {
            if ((cu & 3) == 0) { const int un = cu >> 2, b = un >> 7, h = (un >> 3) & 15, blk = un & 7;
                attn_unit(Q, Kb, VT, O, tab, b, h, MLAT + b * 256 + blk * 32, false, 0, 0, lane); }
        }
    }
    __syncthreads();
}


constexpr int ATT_RING = 3, ATT_BUF = 16384, ATT_TAB_OFF = ATT_RING * ATT_BUF;
template <bool BAND>
__device__ __forceinline__ void attn_tile_lds(const LAS unsigned char* buf, const unsigned (&fo)[4], const bf16x8 (&qr)[4], float& mref, float& l, f32x16& o0, f32x16& o1,
                                              const LAS float* brow, int lo) {
    bf16x8 kf[2][4];
#pragma unroll
    for (int p = 0; p < 2; ++p)
#pragma unroll
        for (int d0 = 0; d0 < 4; ++d0) kf[p][d0] = *(const LAS bf16x8*)(buf + p * 4096 + fo[d0]);
    f32x16 p0, p1;
#pragma unroll
    for (int r = 0; r < 16; ++r) { p0[r] = 0.f; p1[r] = 0.f; }
#pragma unroll
    for (int d0 = 0; d0 < 4; ++d0) { p0 = __builtin_amdgcn_mfma_f32_32x32x16_bf16(kf[0][d0], qr[d0], p0, 0, 0, 0); p1 = __builtin_amdgcn_mfma_f32_32x32x16_bf16(kf[1][d0], qr[d0], p1, 0, 0, 0); }
    bf16x8 vf[2][4];
#pragma unroll
    for (int dh = 0; dh < 2; ++dh)
#pragma unroll
        for (int sl = 0; sl < 4; ++sl) vf[dh][sl] = *(const LAS bf16x8*)(buf + 8192 + dh * 4096 + fo[sl]);
    if (BAND) {
        float b0[16], b1[16];
#pragma unroll
        for (int r = 0; r < 16; ++r) { const int C0 = (r & 3) + 8 * (r >> 2); b0[r] = brow[C0]; b1[r] = brow[C0 + 32]; }
#pragma unroll
        for (int r = 0; r < 16; ++r) { const int C0 = (r & 3) + 8 * (r >> 2);
            const float a0 = p0[r] + b0[r], a1 = p1[r] + b1[r];
            p0[r] = ((unsigned)(C0 - lo) < 16u) ? a0 : -INFINITY;
            p1[r] = ((unsigned)(C0 + 32 - lo) < 16u) ? a1 : -INFINITY; }
    }
    float mt = fmaxf(p0[0], p1[0]);
#pragma unroll
    for (int r = 1; r < 16; ++r) mt = fmaxf(mt, fmaxf(p0[r], p1[r]));
    mt = fmaxf(mt, __shfl_xor(mt, 32));
    if (__any(mt > mref + 8.0f)) {
        const float mnew = (mt > mref + 8.0f) ? mt : mref;
        const float alpha = __builtin_amdgcn_exp2f(mref - mnew);
        l *= alpha;
#pragma unroll
        for (int r = 0; r < 16; ++r) { o0[r] *= alpha; o1[r] *= alpha; }
        mref = mnew;
    }
    float ls = 0.f;
#pragma unroll
    for (int r = 0; r < 16; ++r) { p0[r] = __builtin_amdgcn_exp2f(p0[r] - mref); p1[r] = __builtin_amdgcn_exp2f(p1[r] - mref); ls += p0[r] + p1[r]; }
    l += ls;
    bf16x8 pf[4];
#pragma unroll
    for (int sl = 0; sl < 4; ++sl) {
        u32x4 w;
        if (sl < 2) { const int o = 8 * sl; w.x = cvt_pk_bf16(p0[o], p0[o + 1]); w.y = cvt_pk_bf16(p0[o + 2], p0[o + 3]); w.z = cvt_pk_bf16(p0[o + 4], p0[o + 5]); w.w = cvt_pk_bf16(p0[o + 6], p0[o + 7]); }
        else { const int o = 8 * (sl - 2); w.x = cvt_pk_bf16(p1[o], p1[o + 1]); w.y = cvt_pk_bf16(p1[o + 2], p1[o + 3]); w.z = cvt_pk_bf16(p1[o + 4], p1[o + 5]); w.w = cvt_pk_bf16(p1[o + 6], p1[o + 7]); }
        pf[sl] = __builtin_bit_cast(bf16x8, w);
    }
#pragma unroll
    for (int sl = 0; sl < 4; ++sl) {
        o0 = __builtin_amdgcn_mfma_f32_32x32x16_bf16(vf[0][sl], pf[sl], o0, 0, 0, 0);
        o1 = __builtin_amdgcn_mfma_f32_32x32x16_bf16(vf[1][sl], pf[sl], o1, 0, 0, 0);
    }
}
__device__ __forceinline__ void attn_phase2(const bf16_t* Q, const bf16_t* Kb, const bf16_t* VT, bf16_t* O, const float* rpb, LAS unsigned char* lds, int nrows) {
    const int tid = opaque_tid(), lane = tid & 63, wave = __builtin_amdgcn_readfirstlane(tid >> 6);
    LAS float* tab = (LAS float*)(lds + ATT_TAB_OFF);
    for (int i = tid; i < RPB_N + 2 * RPB_PAD; i += NTHREADS) { const int k = i - RPB_PAD; tab[i] = (k >= 0 && k < RPB_N) ? rpb[k] * LOG2E : 0.f; }
    __syncthreads();
    const int r32 = lane & 31, hi = lane >> 5, sw = (r32 >> 1) & 7;
    unsigned fo[4];
#pragma unroll
    for (int j = 0; j < 4; ++j) fo[j] = (unsigned)(r32 * 128 + (((2 * j + hi) ^ sw) << 4));
    const int drow = 8 * wave + (lane >> 3), dch = (lane & 7) ^ ((drow >> 1) & 7);
    const size_t koff = (size_t)drow * D + dch * 8, voff = (size_t)drow * MTOT + dch * 8;
    const int nitems = 1024 + (nrows == MTOT ? 64 : 0);
    for (int it = blockIdx.x; it < nitems; it += gridDim.x) {
        const bool lat = it < 1024;
        int b, h, m0, R = 0, qc0 = 0, U0 = 0, S = 4, startR = 0;
        if (lat) { const int bh = it >> 4, R0 = 4 * (it & 15); b = bh >> 4; h = bh & 15; R = R0 + (wave >> 1); qc0 = 32 * (wave & 1); m0 = b * 4096 + R * 64 + qc0;
            U0 = min(max(R0 - 4, 0), 56); const int U1 = min(max(R0 - 1, 0), 56) + 8; S = 4 + U1 - U0; startR = min(max(R - 4, 0), 56); }
        else { const int un = it - 1024; b = un >> 4; h = un & 15; m0 = MLAT + b * 256 + 32 * wave; }
        const bf16_t* Kh = Kb + h * 64 + koff; const bf16_t* Vh = VT + (size_t)(h * 64) * MTOT + voff;
        const int ctxbase = MLAT + b * 256, latbase = b * 4096 + U0 * 64;
#define ATT_TOK(s_) ((s_) < 4 ? ctxbase + 64 * (s_) : latbase + 64 * ((s_) - 4))
#define ATT_DMA(s_, bi_) do { const int tk_ = ATT_TOK(s_); const unsigned bo_ = (unsigned)(bi_) * ATT_BUF + (unsigned)wave * 1024u; \
        __builtin_amdgcn_global_load_lds((const unsigned*)(Kh + (size_t)tk_ * D), (LAS unsigned*)(lds + bo_), 16, 0, 0); \
        __builtin_amdgcn_global_load_lds((const unsigned*)(Vh + tk_), (LAS unsigned*)(lds + bo_ + 8192), 16, 0, 0); } while (0)
        ATT_DMA(0, 0); ATT_DMA(1, 1);
        bf16x8 qr[4];
#pragma unroll
        for (int d0 = 0; d0 < 4; ++d0) qr[d0] = *(const bf16x8*)(Q + (size_t)(m0 + r32) * D + h * 64 + 16 * d0 + 8 * hi);
        asm volatile("" : "+v"(qr[0]), "+v"(qr[1]), "+v"(qr[2]), "+v"(qr[3]));
        float mref = -INFINITY, l = 0.f; f32x16 o0, o1;
#pragma unroll
        for (int i = 0; i < 16; ++i) { o0[i] = 0.f; o1[i] = 0.f; }
        const int qc = qc0 + r32, cs = min(max(qc - 8, 0), 48), lo = cs - 4 * hi;
        const LAS float* lb = tab + RPB_PAD + h * 15 * 31 + (4 * hi - qc + 15);
        int bi = 0, bi2 = 2;
        for (int s = 0; s < S; ++s) {
            if (s + 1 < S) asm volatile("s_waitcnt vmcnt(2)" ::: "memory"); else asm volatile("s_waitcnt vmcnt(0)" ::: "memory");
            __builtin_amdgcn_s_barrier();
            asm volatile("" ::: "memory");
            if (s + 2 < S) ATT_DMA(s + 2, bi2);
            const LAS unsigned char* buf = lds + bi * ATT_BUF;
            if (s < 4) attn_tile_lds<false>(buf, fo, qr, mref, l, o0, o1, tab, 0);
            else { const int kr = U0 + s - 4; if (kr >= startR && kr < startR + 8) attn_tile_lds<true>(buf, fo, qr, mref, l, o0, o1, lb + (kr - R + 7) * 31, lo); }
            bi = (bi == ATT_RING - 1) ? 0 : bi + 1; bi2 = (bi2 == ATT_RING - 1) ? 0 : bi2 + 1;
        }
        l += __shfl_xor(l, 32);
        const float inv = 1.0f / l;
        bf16_t* op = O + (size_t)(m0 + r32) * D + h * 64 + 4 * hi;
#pragma unroll
        for (int g = 0; g < 4; ++g) {
            u32x2 w0, w1;
            w0.x = cvt_pk_bf16(o0[4 * g] * inv, o0[4 * g + 1] * inv); w0.y = cvt_pk_bf16(o0[4 * g + 2] * inv, o0[4 * g + 3] * inv);
            w1.x = cvt_pk_bf16(o1[4 * g] * inv, o1[4 * g + 1] * inv); w1.y = cvt_pk_bf16(o1[4 * g + 2] * inv, o1[4 * g + 3] * inv);
            *(u32x2*)(op + 8 * g) = w0; *(u32x2*)(op + 32 + 8 * g) = w1;
        }
        asm volatile("s_waitcnt vmcnt(0) lgkmcnt(0)" ::: "memory");
        __builtin_amdgcn_s_barrier();
        asm volatile("" ::: "memory");
#undef ATT_TOK
#undef ATT_DMA
    }
    __syncthreads();
}

__global__ void __launch_bounds__(NTHREADS, 2) mk_fwd(Args P) {
    extern __shared__ __attribute__((aligned(16))) unsigned char lds_raw[];
    LAS unsigned char* lds = (LAS unsigned char*)lds_raw;
    cg::grid_group grid = cg::this_grid();
    if (threadIdx.x < 2) ((volatile LAS unsigned*)(lds + LDS_MISC_OFF))[threadIdx.x] = 0u;
    __syncthreads();
    const XcdBarrier xbar = xcd_barrier_post((unsigned*)(P.ws + WS_CTL), (volatile LAS unsigned*)(lds + LDS_MISC_OFF));
#define GSYNC() do { xcd_barrier(xbar); for (int _e = 0; _e < EXP_SYNC; ++_e) xcd_barrier(xbar); } while (0)
    const int G = gridDim.x, bx = blockIdx.x;
    unsigned char* ws = P.ws;
    float* mods = (float*)(ws + WS_MODS);
    float* X = (float*)(ws + WS_X);
    bf16_t* H = (bf16_t*)(ws + WS_H);
    bf16_t* Qb = (bf16_t*)(ws + WS_Q); bf16_t* Kb = (bf16_t*)(ws + WS_K); bf16_t* VT = (bf16_t*)(ws + WS_VT); bf16_t* Ob = (bf16_t*)(ws + WS_O);
    bf16_t* Gb = (bf16_t*)(ws + WS_G);
    constexpr size_t TS1024 = (size_t)256 * 1024 * 2;

    for (int _e = 0; _e <= EXP_PRO; ++_e) { prologue_phase(P, lds); __syncthreads(); }
    grid.sync();

    for (int layer = 0; layer < NLAYER; ++layer) {
        const int kind = layer % 3, j = layer / 3;
        const bool lastl = (layer == NLAYER - 1);
        const int nrows = lastl ? MLAT : MTOT;
        const float* mods_l = mods + (size_t)layer * 5 * NMOD;
        const float* xin_lat = layer == 0 ? P.x : X;
        const float* xin_ctx = layer == 0 ? P.ctx : X + (size_t)MLAT * D;

        if (kind == 0) {
            norm_phase(xin_lat, xin_ctx, P.norm_mix_g + layer * D, mods_l, 0, 1, H, MTOT);
            GSYNC();
            {
                const bf16_t* Wt = (const bf16_t*)(ws + WS_WQKV) + (size_t)j * 3 * D * D;
                pg8::Sched S; S.init1(H, TS1024, Wt, TS1024, MTOT / 256, 8, G, bx);
                S.add2(Wt + (size_t)2 * D * D, TS1024, H, TS1024, 4, MTOT / 256);
                pg8::EpiQKV E{Qb, Kb, VT};
                pg8::gemm_phase<pg8::EpiQKV>(lds, D, D, D, S, E);
            }
            GSYNC();
            for (int _e = 0; _e <= EXP_ATTN; ++_e) attn_phase2(Qb, Kb, VT, Ob, P.na_rpb + (size_t)j * NH * 15 * 31, lds, nrows);
            GSYNC();
            {
                const bf16_t* Wt = (const bf16_t*)(ws + WS_WO) + (size_t)j * D * D;
                pg8::Sched S; S.init1(Ob, TS1024, Wt, TS1024, nrows / 256, 4, G, bx);
                pg8::EpiRes E{xin_lat, xin_ctx, X, mods_l + 2 * D, nullptr};
                pg8::gemm_phase<pg8::EpiRes>(lds, D, D, D, S, E);
            }
            GSYNC();
        } else if (kind == 1) {
            norm_phase(xin_lat, xin_ctx, P.norm_mix_g + layer * D, mods_l, 0, 1, H, MTOT);
            GSYNC();
            {
                const bf16_t* Wt = (const bf16_t*)(ws + WS_WSCIN);
                pg8::Sched S; S.init1(H, TS1024, Wt, TS1024, MTOT / 256, 12, G, bx);
                pg8::EpiSCin E{Qb, Kb};
                pg8::gemm_phase<pg8::EpiSCin>(lds, D, D, D, S, E);
            }
            GSYNC();
            conv_phase(Qb, Kb, P.sc_conv_w + (size_t)j * 3 * D, Ob);
            GSYNC();
            {
                const bf16_t* Wt = (const bf16_t*)(ws + WS_WSCOUT);
                pg8::Sched S; S.init1(Ob, TS1024, Wt, TS1024, nrows / 256, 4, G, bx);
                pg8::EpiRes E{xin_lat, xin_ctx, X, mods_l + 2 * D, nullptr};
                pg8::gemm_phase<pg8::EpiRes>(lds, D, D, D, S, E);
            }
            GSYNC();
        } else {
            pool_phase(X, P.norm_mix_g + layer * D, mods_l, H, (LAS float*)lds);
            GSYNC();
            {
                const bf16_t* Wt = (const bf16_t*)(ws + WS_WPOOL);
                pg8::Sched S; S.init1(H, TS1024, Wt, (size_t)256 * 256 * 2, nrows / 256, 4, G, bx); S.apn = 512;
                pg8::EpiRes E{xin_lat, xin_ctx, X, mods_l + 2 * D, P.pool_scale + (size_t)j * D};
                pg8::gemm_phase<pg8::EpiRes>(lds, 256, D, 256, S, E);
            }
            GSYNC();
        }
        for (int _e = 0; _e <= EXP_NORM; ++_e) norm_phase(X, X + (size_t)MLAT * D, P.norm_ffn_g + layer * D, mods_l, 3, 4, H, nrows);
        GSYNC();
        {
            const bf16_t* Wt = (const bf16_t*)(ws + WS_W13) + (size_t)layer * 2 * FF * D;
            pg8::Sched S; S.init1(H, TS1024, Wt, TS1024, nrows / 256, 2 * FF / 256, G, bx);
            pg8::EpiSwi E{Gb};
            for (int _e = 0; _e <= EXP_UP; ++_e) pg8::gemm_phase<pg8::EpiSwi>(lds, D, D, D, S, E);
        }
        GSYNC();
        {
            const bf16_t* Wt = (const bf16_t*)(ws + WS_W2) + (size_t)layer * D * FF;
            pg8::Sched S; S.init1(Gb, (size_t)256 * FF * 2, Wt, (size_t)256 * FF * 2, nrows / 256, 4, G, bx);
            pg8::EpiRes E{X, X + (size_t)MLAT * D, X, mods_l + 5 * D, nullptr};
            pg8::gemm_phase<pg8::EpiRes>(lds, FF, FF, FF, S, E);
        }
        GSYNC();
    }
    final_norm_phase(X, P.final_g, P.out);
}

extern "C" void kernel_launch(void* const* d_in, const int* in_sizes, int n_in, void* d_out, int out_size, void* d_ws, size_t ws_size, hipStream_t stream) {
    static int grid = 0;
    if (grid == 0) {
        if (n_in != 20 || ws_size < WS_END) { fprintf(stderr, "kernel_launch: unexpected n_in %d / ws_size %zu\n", n_in, ws_size); grid = -1; return; }
        int dev = 0, cus = 0, per_cu = 0;
        hipGetDevice(&dev);
        hipDeviceGetAttribute(&cus, hipDeviceAttributeMultiprocessorCount, dev);
        if (hipFuncSetAttribute((const void*)mk_fwd, hipFuncAttributeMaxDynamicSharedMemorySize, LDS_BYTES) != hipSuccess) { fprintf(stderr, "kernel_launch: hipFuncSetAttribute failed\n"); }
        if (hipOccupancyMaxActiveBlocksPerMultiprocessor(&per_cu, (const void*)mk_fwd, NTHREADS, LDS_BYTES) != hipSuccess || per_cu < 1) { fprintf(stderr, "kernel_launch: occupancy query says %d\n", per_cu); per_cu = 1; }
        (void)hipGetLastError();
        grid = cus * 1;
        if (grid <= 0) grid = 256;
    }
    if (grid < 0) return;
    if (hipMemsetAsync((char*)d_ws + WS_CTL, 0, CTL_ZERO_BYTES, stream) != hipSuccess) { fprintf(stderr, "kernel_launch: memset failed\n"); return; }
    Args a{};
    const float** f = (const float**)&a;
    for (int i = 0; i < 20; ++i) f[i] = (const float*)d_in[i];
    a.out = (float*)d_out; a.ws = (unsigned char*)d_ws;
    void* args[] = {&a};
    hipError_t e = hipLaunchCooperativeKernel((const void*)mk_fwd, dim3(grid), dim3(NTHREADS), args, LDS_BYTES, stream);
    if (e != hipSuccess) fprintf(stderr, "cooperative launch failed: %s (grid %d)\n", hipGetErrorString(e), grid);
}
```
